# Optimizing an MI355X kernel written in HIP

```python
import functools
import jax, jax.numpy as jnp
from jax import lax
import numpy as np

D_MODEL = 2048
BATCH = 32
SEQ = 256
DEPTH = 4
DEC_BATCH = 2
DEC_SEQ = 1024
PAST_LEN = 512

GRID_W = 64
HEAD_DIM = 128
ATT_HEADS = 8
KV_HEADS = 2
Q_PER_KV = ATT_HEADS // KV_HEADS
ATT_DIM = ATT_HEADS * HEAD_DIM
KV_DIM = KV_HEADS * HEAD_DIM
WINDOW = 128
BLOCK = 128
ATT_SCALE = HEAD_DIM ** -0.5
ROPE_THETA = 10000.0
ROPE_FREQS = HEAD_DIM // 4
HG_HEADS = 8
HG_DK = 128
HG_DV = 128
HG_DIM = HG_HEADS * HG_DK
HG_VDIM = HG_HEADS * HG_DV
HG_CHUNK = 32
MIX_DIM = ATT_DIM + HG_VDIM
IN_DIM = ATT_DIM + 2 * KV_DIM + 3 * HG_DIM + 2 * HG_VDIM
D_FF = 4 * D_MODEL
LN_EPS = 1e-5
RMS_EPS = 1e-6
DEEPNORM_ALPHA = (2 * DEPTH) ** 0.25
DEEPNORM_BETA = (8 * DEPTH) ** -0.25
NEG_INF = -1e30
F32 = jnp.float32

kernel_name = 'hybrid_swa_hgrn2_diffusion_step'


def layer_norm(x, g, b):
    xf = x.astype(F32)
    xc = xf - jnp.mean(xf, -1, keepdims=True)
    var = jnp.mean(xc * xc, -1, keepdims=True)
    return (xc * lax.rsqrt(var + LN_EPS) * g.astype(F32) + b.astype(F32)).astype(x.dtype)


def rms_norm(x, g):
    xf = x.astype(F32)
    return (xf * lax.rsqrt(jnp.mean(xf * xf, -1, keepdims=True) + RMS_EPS) * g.astype(F32)).astype(x.dtype)


def modulation(c, w_mod_l, b_mod_l):
    return jnp.split(jax.nn.silu(c) @ w_mod_l + b_mod_l, 6, axis=-1)


def modulate(x, shift, scale):
    return x * (1 + scale) + shift


def split_in(z):
    cuts = np.cumsum([ATT_DIM, KV_DIM, KV_DIM, HG_DIM, HG_DIM, HG_DIM, HG_VDIM]).tolist()
    return jnp.split(z, cuts, axis=-1)


def axial_angles(n_tokens):
    rows = n_tokens // GRID_W
    row = jnp.repeat(jnp.arange(rows, dtype=F32), GRID_W)
    col = jnp.tile(jnp.arange(GRID_W, dtype=F32), rows)
    inv = ROPE_THETA ** (-jnp.arange(ROPE_FREQS, dtype=F32) / ROPE_FREQS)
    return row[:, None] * inv, col[:, None] * inv


def rope_axis(x, ang):
    cos = jnp.cos(ang).astype(x.dtype)[None, :, None, :]
    sin = jnp.sin(ang).astype(x.dtype)[None, :, None, :]
    x1, x2 = x[..., :ROPE_FREQS], x[..., ROPE_FREQS:]
    return jnp.concatenate([x1 * cos - x2 * sin, x1 * sin + x2 * cos], -1)


def axial_rope(x, ang_r, ang_c):
    half = HEAD_DIM // 2
    return jnp.concatenate([rope_axis(x[..., :half], ang_r), rope_axis(x[..., half:], ang_c)], -1)


def softmax_with_sink(s, sink):
    sk = sink.astype(F32).reshape(KV_HEADS, Q_PER_KV, 1, 1)
    m = jnp.maximum(jnp.max(s, -1, keepdims=True), sk)
    e = jnp.exp(s - m)
    return e / (jnp.sum(e, -1, keepdims=True) + jnp.exp(sk - m))


def context_attention(q, k, v, sink):
    B, T = q.shape[0], q.shape[1]
    nb = T // BLOCK
    qb = jnp.swapaxes(q.reshape(B, nb, BLOCK, KV_HEADS, Q_PER_KV, HEAD_DIM), 0, 1)

    def one_block(qblk):
        s = jnp.einsum('bqgrd,bkgd->bgrqk', qblk, k, preferred_element_type=F32) * ATT_SCALE
        p = softmax_with_sink(s, sink).astype(v.dtype)
        return jnp.einsum('bgrqk,bkgd->bqgrd', p, v)

    o = lax.map(one_block, qb)
    return jnp.swapaxes(o, 0, 1).reshape(B, T, ATT_DIM)


def latent_attention(q, k, v, sink, ang_r, ang_c, k_ctx, v_ctx):
    B, T = q.shape[0], q.shape[1]
    nb = T // BLOCK
    q = axial_rope(q, ang_r, ang_c)
    k = axial_rope(k, ang_r, ang_c)
    qb = q.reshape(B, nb, BLOCK, KV_HEADS, Q_PER_KV, HEAD_DIM)

    def neighbours(a):
        ap = jnp.pad(a, ((0, 0), (BLOCK, BLOCK), (0, 0), (0, 0))).reshape(B, nb + 2, BLOCK, KV_HEADS, HEAD_DIM)
        return jnp.concatenate([ap[:, :-2], ap[:, 1:-1], ap[:, 2:]], axis=2)

    kb, vb = neighbours(k), neighbours(v)
    qpos = jnp.arange(nb)[:, None] * BLOCK + jnp.arange(BLOCK)[None, :]
    kpos = jnp.arange(nb)[:, None] * BLOCK - BLOCK + jnp.arange(3 * BLOCK)[None, :]
    kp = kpos[:, None, :]
    valid = (kp >= 0) & (kp < T) & (jnp.abs(kp - qpos[:, :, None]) <= WINDOW)
    s_loc = jnp.einsum('bnqgrd,bnkgd->bngrqk', qb, kb, preferred_element_type=F32) * ATT_SCALE
    s_loc = jnp.where(valid[None, :, None, None], s_loc, NEG_INF)
    s_ctx = jnp.einsum('bnqgrd,bpgd->bngrqp', qb, k_ctx, preferred_element_type=F32) * ATT_SCALE
    p = softmax_with_sink(jnp.concatenate([s_loc, s_ctx], -1), sink).astype(v.dtype)
    o = (jnp.einsum('bngrqk,bnkgd->bnqgrd', p[..., :3 * BLOCK], vb)
         + jnp.einsum('bngrqp,bpgd->bnqgrd', p[..., 3 * BLOCK:], v_ctx))
    return o.reshape(B, T, ATT_DIM)


def hgrn_chunk_scan(q, k, v, log_f, s0):
    B, T, H, _ = q.shape
    n, C = T // HG_CHUNK, HG_CHUNK

    def chunks(a):
        return a.reshape(B, n, C, H, a.shape[-1]).astype(F32)

    qc, kc, vc = chunks(q), chunks(k), chunks(v)
    b = jnp.cumsum(chunks(log_f), axis=2)
    b_mid = b[:, :, C // 2 - 1:C // 2]
    b_last = b[:, :, C - 1:C]
    a = jnp.einsum('bnthk,bnshk->bnhts', qc * jnp.exp(b - b_mid), kc * jnp.exp(b_mid - b))
    a = jnp.where(jnp.tril(jnp.ones((C, C), bool)), a, 0.0)
    o_intra = jnp.einsum('bnhts,bnshv->bnthv', a, vc)
    decay = jnp.exp(b_last[:, :, 0])
    u = jnp.einsum('bnshk,bnshv->bnhkv', kc * jnp.exp(b_last - b), vc)

    def step(s, inp):
        d, uu = inp
        return d[..., None] * s + uu, s

    s_final, s_starts = lax.scan(step, s0.astype(F32), (jnp.moveaxis(decay, 1, 0), jnp.moveaxis(u, 1, 0)))
    o_inter = jnp.einsum('bnthk,bnhkv->bnthv', qc * jnp.exp(b), jnp.moveaxis(s_starts, 0, 1))
    o = (o_intra + o_inter).reshape(B, T, H, v.shape[-1])
    return o.astype(v.dtype), s_final.astype(v.dtype)


def hgrn_mixer(hq, hff, hfb, hi, hgt, lb_f, lb_b, norm_g, s_f0, s_b0):
    B, T, _ = hq.shape
    q = jax.nn.silu(hq).reshape(B, T, HG_HEADS, HG_DK)
    v = hi.reshape(B, T, HG_HEADS, HG_DV)

    def gates(z, lb):
        zf = z.reshape(B, T, HG_HEADS, HG_DK).astype(F32)
        lbh = lb.reshape(HG_HEADS, HG_DK)
        log_f = jnp.log(lbh + (1 - lbh) * jax.nn.sigmoid(zf))
        k = ((1 - lbh) * jax.nn.sigmoid(-zf)).astype(v.dtype)
        return log_f, k

    logf_f, k_f = gates(hff, lb_f)
    logf_b, k_b = gates(hfb, lb_b)
    o_f, s_f = hgrn_chunk_scan(q, k_f, v, logf_f, s_f0)
    flip = lambda a: jnp.flip(a, axis=1)
    o_b, s_b = hgrn_chunk_scan(flip(q), flip(k_b), flip(v), flip(logf_b), s_b0)
    o = rms_norm(o_f + flip(o_b), norm_g) * jax.nn.silu(hgt.reshape(B, T, HG_HEADS, HG_DV))
    return o.reshape(B, T, HG_VDIM), s_f, s_b


def lower_bounds(lb_logits):
    p = jax.nn.softmax(lb_logits.astype(F32), axis=0)
    cs = jnp.cumsum(p, axis=0)
    return cs - cs[0:1]


def sq_relu_mlp(h, w_up, w_down):
    return jnp.square(jax.nn.relu(h @ w_up)) @ w_down


def hybrid_layer(x, mods, w_in_l, sink_l, attn_g_l, lb_f_l, lb_b_l, hg_g_l, w_o_l, ln_g_l, ln_b_l,
                 w_up_l, w_down_l, s_f0, s_b0, attend):
    shift1, scale1, gate1, shift2, scale2, gate2 = mods
    B, T, _ = x.shape
    h = modulate(x, shift1, scale1)
    q, k, v, hq, hff, hfb, hi, hgt = split_in(h @ w_in_l)
    q = q.reshape(B, T, ATT_HEADS, HEAD_DIM)
    k = k.reshape(B, T, KV_HEADS, HEAD_DIM)
    v = v.reshape(B, T, KV_HEADS, HEAD_DIM)
    att = rms_norm(attend(q, k, v, sink_l), attn_g_l)
    hg, s_f, s_b = hgrn_mixer(hq, hff, hfb, hi, hgt, lb_f_l, lb_b_l, hg_g_l, s_f0, s_b0)
    mix = jnp.concatenate([att, hg], -1) @ w_o_l
    x = layer_norm(DEEPNORM_ALPHA * x + gate1 * mix, ln_g_l[0], ln_b_l[0])
    ffn = sq_relu_mlp(modulate(x, shift2, scale2), w_up_l, w_down_l)
    x = layer_norm(DEEPNORM_ALPHA * x + gate2 * ffn, ln_g_l[1], ln_b_l[1])
    return x, k, v, s_f, s_b


def setup_inputs(seed: int = 0) -> dict:
    key = jax.random.key(seed)
    ks = jax.random.split(key, 20)

    def nrm(k, shape, s):
        return jax.random.normal(k, shape, F32) * s

    return {
        'x_prompt': nrm(ks[0], (BATCH, SEQ, D_MODEL), 1.0),
        'x_sample': nrm(ks[1], (DEC_BATCH, DEC_SEQ, D_MODEL), 1.0),
        'cache_k': nrm(ks[2], (DEC_BATCH, DEPTH, PAST_LEN, KV_HEADS, HEAD_DIM), 1.0),
        'cache_v': nrm(ks[3], (DEC_BATCH, DEPTH, PAST_LEN, KV_HEADS, HEAD_DIM), 1.0),
        'state_hgrn_fwd': nrm(ks[4], (DEC_BATCH, DEPTH, HG_HEADS, HG_DK, HG_DV), 0.5),
        'state_hgrn_bwd': nrm(ks[5], (DEC_BATCH, DEPTH, HG_HEADS, HG_DK, HG_DV), 0.5),
        'c': nrm(ks[6], (DEC_BATCH, D_MODEL), 1.0),
        'c_ctx': nrm(ks[7], (D_MODEL,), 1.0),
        'w_mod': nrm(ks[8], (DEPTH, D_MODEL, 6 * D_MODEL), 0.5 * D_MODEL ** -0.5),
        'b_mod': nrm(ks[9], (DEPTH, 6 * D_MODEL), 0.02),
        'w_in': nrm(ks[10], (DEPTH, D_MODEL, IN_DIM), D_MODEL ** -0.5),
        'attn_sink': nrm(ks[11], (DEPTH, ATT_HEADS), 0.5),
        'attn_norm_g': 1.0 + nrm(ks[12], (DEPTH, ATT_DIM), 0.02),
        'hg_lb_logits': nrm(ks[13], (2, DEPTH, HG_DIM), 0.5),
        'hg_norm_g': 1.0 + nrm(ks[14], (DEPTH, HG_DV), 0.02),
        'w_o': nrm(ks[15], (DEPTH, MIX_DIM, D_MODEL), MIX_DIM ** -0.5 * DEEPNORM_BETA),
        'ln_g': 1.0 + nrm(ks[16], (DEPTH, 2, D_MODEL), 0.02),
        'ln_b': nrm(ks[17], (DEPTH, 2, D_MODEL), 0.02),
        'w_up': nrm(ks[18], (DEPTH, D_MODEL, D_FF), D_MODEL ** -0.5),
        'w_down': nrm(ks[19], (DEPTH, D_FF, D_MODEL), D_FF ** -0.5 * DEEPNORM_BETA),
    }


def reference(x_prompt, x_sample, cache_k, cache_v, state_hgrn_fwd, state_hgrn_bwd, c, c_ctx,
              w_mod, b_mod, w_in, attn_sink, attn_norm_g, hg_lb_logits, hg_norm_g, w_o, ln_g, ln_b,
              w_up, w_down):
    lb_fwd = lower_bounds(hg_lb_logits[0]).astype(x_prompt.dtype)
    lb_bwd = lower_bounds(hg_lb_logits[1]).astype(x_prompt.dtype)
    Bp = x_prompt.shape[0]
    Ts = x_sample.shape[1]
    ang_r, ang_c = axial_angles(Ts)
    zero_state = jnp.zeros((Bp, HG_HEADS, HG_DK, HG_DV), x_prompt.dtype)
    xp, xs = x_prompt, x_sample
    new_k, new_v, new_sf, new_sb = [], [], [], []
    for l in range(DEPTH):
        mods_ctx = modulation(c_ctx, w_mod[l], b_mod[l])
        xp, k_c, v_c, s_f, s_b = hybrid_layer(
            xp, mods_ctx, w_in[l], attn_sink[l], attn_norm_g[l], lb_fwd[l], lb_bwd[l], hg_norm_g[l],
            w_o[l], ln_g[l], ln_b[l], w_up[l], w_down[l], zero_state, zero_state, context_attention)
        new_k.append(k_c)
        new_v.append(v_c)
        new_sf.append(s_f)
        new_sb.append(s_b)
        mods_lat = [m[:, None, :] for m in modulation(c, w_mod[l], b_mod[l])]
        attend_lat = functools.partial(latent_attention, ang_r=ang_r, ang_c=ang_c,
                                       k_ctx=cache_k[:, l], v_ctx=cache_v[:, l])
        xs, _, _, _, _ = hybrid_layer(
            xs, mods_lat, w_in[l], attn_sink[l], attn_norm_g[l], lb_fwd[l], lb_bwd[l], hg_norm_g[l],
            w_o[l], ln_g[l], ln_b[l], w_up[l], w_down[l], state_hgrn_fwd[:, l], state_hgrn_bwd[:, l], attend_lat)
    new_cache_k = jnp.stack(new_k, axis=1)
    new_cache_v = jnp.stack(new_v, axis=1)
    new_state_hgrn_fwd = jnp.stack(new_sf, axis=1)
    new_state_hgrn_bwd = jnp.stack(new_sb, axis=1)
    return (xp, xs, new_cache_k, new_cache_v, new_state_hgrn_fwd, new_state_hgrn_bwd)
```

```cpp
#include <hip/hip_runtime.h>
#include <cstdio>
#include <cstdint>
namespace pg8 {
#define PG8_LAS __attribute__((address_space(3)))
typedef unsigned short bf16_t;
typedef short bf16x8 __attribute__((ext_vector_type(8)));
typedef float f32x4 __attribute__((ext_vector_type(4)));
typedef unsigned u32x4 __attribute__((ext_vector_type(4)));
constexpr int BM = 256, BK = 64, HALF = 128, HTB = HALF * BK * 2  , STAGE_BYTES = 8 * HTB, NXCD = 8, WGM = 8;

__host__ __device__ __forceinline__ int lds_byte(int r, int c) { const int st = (r >> 4) * 2 + (c >> 5), rr = r & 15, cc = c & 31, ob = rr * 64 + cc * 2; return st * 1024 + (ob ^ (((ob >> 9) & 1) << 5)); }
__host__ __device__ __forceinline__ void stage_rc(int b, int& R, int& C) { const int st = b / 1024, sb = b % 1024, swz = sb ^ (((sb >> 9) & 1) << 5); R = (st >> 1) * 16 + swz / 64; C = (st & 1) * 32 + (swz % 64) / 2; }
__host__ __device__ __forceinline__ int perm32(int rho) { const int n = rho >> 4, i = rho & 15; return 8 * (i >> 2) + 4 * n + (i & 3); }

struct Unit { int pm, pn, ks; };
struct Gemm { const bf16_t* A; const bf16_t* Bt; int M, N, K, ld; size_t ksA, ksB; };

struct StaticOrder {
    int nM, nN, nwg, G, c;
    __host__ __device__ void init(int M, int N, int G_, int c_) { nM = M / BM; nN = N / BM; nwg = nM * nN; G = G_; c = c_; }
    __host__ __device__ bool next(int i, Unit& u) const {
        const long L = (long)i * G + c; if (L >= nwg) return false;
        int wgid = (int)L; { const int q = nwg / NXCD, r = nwg % NXCD, xcd = wgid % NXCD, off = wgid / NXCD; wgid = (xcd < r ? xcd * (q + 1) : r * (q + 1) + (xcd - r) * q) + off; }
        const int nig = WGM * nN, gid = wgid / nig, fm = gid * WGM, gsz = (nM - fm) < WGM ? (nM - fm) : WGM;
        u.pm = fm + ((wgid % nig) % gsz); u.pn = (wgid % nig) / gsz; u.ks = 0; return true;
    }
    __device__ __forceinline__ void a_ready(const Unit&) const {}
    __device__ __forceinline__ void done(const Unit&) const {}
};

__device__ __forceinline__ unsigned cvt_pk_bf16(float lo, float hi) { unsigned r; asm volatile("v_cvt_pk_bf16_f32 %0, %1, %2" : "=v"(r) : "v"(lo), "v"(hi)); return r; }
template <class Epi, class Sched, bool ALIGN_EPI = false, bool SP2 = false>
__device__ __forceinline__ void gemm_phase(PG8_LAS unsigned char* lds, const Gemm g, const Sched& S, const Epi& E) {
    int tid_o = threadIdx.x; asm volatile("" : "+v"(tid_o));
    const int tid = tid_o, wid = __builtin_amdgcn_readfirstlane(tid >> 6), lane = tid & 63, wr = wid >> 2, wc = wid & 3, fr = lane & 15, fq = lane >> 4;
    const int K = g.K, nt = K / BK, LD = g.ld;
    unsigned voffA[2], voffB[2];
#pragma unroll
    for (int i = 0; i < 2; ++i) { int R, C; stage_rc(tid * 16 + i * 8192, R, C); const int Rb = Epi::PERM ? ((R & ~31) + perm32(R & 31)) : R;
        voffA[i] = (unsigned)(R * LD + C) * 2u; voffB[i] = (unsigned)(Rb * LD + C) * 2u; }
    const size_t kstep = (size_t)(BK * 2);
    const size_t hstep = (size_t)HALF * LD * 2;
    const size_t tstep = 2 * hstep;
    const unsigned ldsw = (unsigned)wid * 1024u;
    const int aoff = lds_byte(wr * 64 + fr, fq * 8), boff = lds_byte(wc * 32 + fr, fq * 8);
#define PG8_SA(b, h) (((b) * 2 + (h)) * HTB)
#define PG8_SB(b, h) ((4 + (b) * 2 + (h)) * HTB)
#define PG8_STAGE(bufoff, gbase, voff) do { _Pragma("unroll") for (int _i = 0; _i < 2; ++_i) \
        __builtin_amdgcn_global_load_lds((const unsigned*)((const char*)(gbase) + (voff)[_i]), (PG8_LAS unsigned*)(lds + (bufoff) + ldsw + _i * 8192), 16, 0, 0); } while (0)
#define PG8_LDA(dst, b, h) do { _Pragma("unroll") for (int m = 0; m < 4; ++m) _Pragma("unroll") for (int k = 0; k < 2; ++k) dst[m][k] = *(const PG8_LAS bf16x8*)(lds + PG8_SA(b, h) + aoff + m * 2048 + k * 1024); } while (0)
#define PG8_LDB(dst, b, h) do { _Pragma("unroll") for (int n = 0; n < 2; ++n) _Pragma("unroll") for (int k = 0; k < 2; ++k) dst[n][k] = *(const PG8_LAS bf16x8*)(lds + PG8_SB(b, h) + boff + n * 2048 + k * 1024); } while (0)
#define PG8_MMA(ai, bj, At, Bt) do { __builtin_amdgcn_s_setprio(1); _Pragma("unroll") for (int m = 0; m < 4; ++m) _Pragma("unroll") for (int n = 0; n < 2; ++n) _Pragma("unroll") for (int k = 0; k < 2; ++k) \
        acc[ai][bj][m][n] = __builtin_amdgcn_mfma_f32_16x16x32_bf16(Bt[n][k], At[m][k], acc[ai][bj][m][n], 0, 0, 0); __builtin_amdgcn_s_setprio(0); } while (0)
#define PG8_WAIT_V(n) asm volatile("s_waitcnt vmcnt(" #n ")" ::: "memory")
#define PG8_WAIT_L(n) asm volatile("s_waitcnt lgkmcnt(" #n ")" ::: "memory")
#define PG8_BAR __builtin_amdgcn_s_barrier()
#define PG8_SCHED __builtin_amdgcn_sched_barrier(0)
    Unit cur, nxt; int ui = 0;
    if (!S.next(0, cur)) return;
    f32x4 acc[2][2][4][2];
#pragma unroll
    for (int a = 0; a < 2; ++a)
#pragma unroll
        for (int b = 0; b < 2; ++b)
#pragma unroll
            for (int m = 0; m < 4; ++m)
#pragma unroll
                for (int n = 0; n < 2; ++n) acc[a][b][m][n] = (f32x4){0.f, 0.f, 0.f, 0.f};
    bf16x8 At[4][2], B0[2][2], B1[2][2];
        const char* cA = (const char*)g.A + (size_t)cur.pm * tstep + (size_t)cur.ks * g.ksA; const char* cB = (const char*)g.Bt + (size_t)cur.pn * tstep + (size_t)cur.ks * g.ksB;
    S.a_ready(cur);
    if constexpr (SP2) {
        PG8_STAGE(PG8_SB(0, 0), cB, voffB); PG8_STAGE(PG8_SB(0, 1), cB + hstep, voffB); PG8_STAGE(PG8_SA(0, 0), cA, voffA); PG8_STAGE(PG8_SA(0, 1), cA + hstep, voffA);
        if (wr == 1) PG8_BAR;
        PG8_WAIT_V(2); PG8_BAR;
        PG8_STAGE(PG8_SB(1, 0), cB + kstep, voffB); PG8_STAGE(PG8_SA(1, 0), cA + kstep, voffA); PG8_STAGE(PG8_SB(1, 1), cB + hstep + kstep, voffB);
        PG8_WAIT_V(6); PG8_BAR;
    } else {
        PG8_STAGE(PG8_SB(0, 0), cB, voffB); PG8_STAGE(PG8_SA(0, 0), cA, voffA); PG8_STAGE(PG8_SB(0, 1), cB + hstep, voffB); PG8_STAGE(PG8_SA(0, 1), cA + hstep, voffA);
        if (wr == 1) PG8_BAR;
        PG8_WAIT_V(4); PG8_BAR;
        PG8_STAGE(PG8_SB(1, 0), cB + kstep, voffB); PG8_STAGE(PG8_SA(1, 0), cA + kstep, voffA); PG8_STAGE(PG8_SB(1, 1), cB + hstep + kstep, voffB);
        PG8_WAIT_V(6); PG8_BAR;
    }
    for (;;) {
        const bool has_next = S.next(ui + 1, nxt);
        const char* nA = has_next ? (const char*)g.A + (size_t)nxt.pm * tstep + (size_t)nxt.ks * g.ksA : cA; const char* nB = has_next ? (const char*)g.Bt + (size_t)nxt.pn * tstep + (size_t)nxt.ks * g.ksB : cB;
        for (int t = 0; t < nt; t += 2) {
            const bool last = (t == nt - 2);
            const char* a1 = cA + (size_t)(t + 1) * kstep;
            const char* a2 = last ? nA : cA + (size_t)(t + 2) * kstep; const char* b2 = last ? nB : cB + (size_t)(t + 2) * kstep;
            const char* a3 = a2 + kstep; const char* b3 = b2 + kstep;
            if (last && has_next) S.a_ready(nxt);
            if constexpr (SP2) {
            PG8_LDB(B0, 0, 0); PG8_LDB(B1, 0, 1); PG8_SCHED; PG8_LDA(At, 0, 0); PG8_STAGE(PG8_SA(1, 1), a1 + hstep, voffA);
            PG8_WAIT_V(8); PG8_WAIT_L(0); PG8_BAR; PG8_MMA(0, 0, At, B0); PG8_MMA(0, 1, At, B1); PG8_BAR; PG8_SCHED;
            PG8_LDA(At, 0, 1); PG8_STAGE(PG8_SB(0, 0), b2, voffB); PG8_STAGE(PG8_SB(0, 1), b2 + hstep, voffB); PG8_STAGE(PG8_SA(0, 0), a2, voffA);
            PG8_WAIT_V(8); PG8_WAIT_L(0); PG8_BAR; PG8_MMA(1, 0, At, B0); PG8_MMA(1, 1, At, B1); PG8_BAR; PG8_SCHED;
            PG8_LDB(B0, 1, 0); PG8_LDB(B1, 1, 1); PG8_SCHED; PG8_LDA(At, 1, 0); PG8_STAGE(PG8_SA(0, 1), a2 + hstep, voffA);
            PG8_WAIT_V(8); PG8_WAIT_L(0); PG8_BAR; PG8_MMA(0, 0, At, B0); PG8_MMA(0, 1, At, B1); PG8_BAR; PG8_SCHED;
            PG8_LDA(At, 1, 1); PG8_STAGE(PG8_SB(1, 0), b3, voffB); PG8_STAGE(PG8_SB(1, 1), b3 + hstep, voffB); PG8_STAGE(PG8_SA(1, 0), a3, voffA);
            PG8_WAIT_V(8); PG8_WAIT_L(0); PG8_BAR; PG8_MMA(1, 0, At, B0); PG8_MMA(1, 1, At, B1); PG8_BAR; PG8_SCHED;
            } else {
            PG8_LDB(B0, 0, 0); PG8_SCHED; PG8_LDA(At, 0, 0); PG8_STAGE(PG8_SA(1, 1), a1 + hstep, voffA);
            PG8_WAIT_L(8); PG8_BAR; PG8_WAIT_L(0); PG8_MMA(0, 0, At, B0); PG8_BAR; PG8_SCHED;
            PG8_LDB(B1, 0, 1); PG8_STAGE(PG8_SB(0, 0), b2, voffB);
            PG8_BAR; PG8_WAIT_L(0); PG8_MMA(0, 1, At, B1); PG8_BAR;
            PG8_LDA(At, 0, 1); PG8_STAGE(PG8_SA(0, 0), a2, voffA);
            PG8_BAR; PG8_WAIT_L(0); PG8_MMA(1, 0, At, B0); PG8_BAR; PG8_SCHED;
            PG8_STAGE(PG8_SB(0, 1), b2 + hstep, voffB);
            PG8_WAIT_V(6); PG8_BAR; PG8_MMA(1, 1, At, B1); PG8_BAR;
            PG8_LDB(B0, 1, 0); PG8_SCHED; PG8_LDA(At, 1, 0); PG8_STAGE(PG8_SA(0, 1), a2 + hstep, voffA);
            PG8_WAIT_L(8); PG8_BAR; PG8_WAIT_L(0); PG8_MMA(0, 0, At, B0); PG8_BAR; PG8_SCHED;
            PG8_LDB(B1, 1, 1); PG8_STAGE(PG8_SB(1, 0), b3, voffB);
            PG8_BAR; PG8_WAIT_L(0); PG8_MMA(0, 1, At, B1); PG8_BAR;
            PG8_LDA(At, 1, 1); PG8_STAGE(PG8_SA(1, 0), a3, voffA);
            PG8_BAR; PG8_WAIT_L(0); PG8_MMA(1, 0, At, B0); PG8_BAR; PG8_SCHED;
            PG8_STAGE(PG8_SB(1, 1), b3 + hstep, voffB);
            PG8_WAIT_V(6); PG8_BAR; PG8_MMA(1, 1, At, B1); PG8_BAR;
            }
        }
        if constexpr (ALIGN_EPI) { if (wr == 0) PG8_BAR; }
        if constexpr (!Epi::AFTER_DRAIN) { E(acc, cur, wr, wc, fr, fq); S.done(cur); }
        if (!has_next) break;
#pragma unroll
        for (int a = 0; a < 2; ++a)
#pragma unroll
            for (int b = 0; b < 2; ++b)
#pragma unroll
                for (int m = 0; m < 4; ++m)
#pragma unroll
                    for (int n = 0; n < 2; ++n) acc[a][b][m][n] = (f32x4){0.f, 0.f, 0.f, 0.f};
        cur = nxt; cA = nA; cB = nB; ++ui;
        if constexpr (ALIGN_EPI) { if (wr == 1) PG8_BAR; }
    }
    PG8_WAIT_V(0);
    if constexpr (!ALIGN_EPI) { if (wr == 0) PG8_BAR; }
    PG8_BAR;
    if constexpr (Epi::AFTER_DRAIN) { E.fused(acc, cur, wr, wc, fr, fq, lds, wid, lane); S.done(cur); }
#undef PG8_SA
#undef PG8_SB
#undef PG8_STAGE
#undef PG8_LDA
#undef PG8_LDB
#undef PG8_MMA
#undef PG8_WAIT_V
#undef PG8_WAIT_L
#undef PG8_BAR
#undef PG8_SCHED
}
}

namespace att {
typedef unsigned short bf16;
using bf16x8 = __attribute__((ext_vector_type(8))) short;
using s16x4  = __attribute__((ext_vector_type(4))) short;
using f32x16 = __attribute__((ext_vector_type(16))) float;
using u32x4  = __attribute__((ext_vector_type(4))) unsigned;
constexpr int   D = 128, NW = 8, QBLK = 32, KVBLK = 64, LDQ = 1024, LDK = 256, LDO = 1024;
constexpr float SCALE = 0.088388347648318440f, THR = 8.f;
constexpr size_t SHM_V = KVBLK * D * 2, SHM_K = KVBLK * D * 2, SHM_ATTN = 2 * SHM_V + 2 * SHM_K + NW * 64 * 4;
#define KSWZ(row, colB) ((row) * 256 + ((colB) ^ (((row) & 7) << 4)))
#define SBAR() __builtin_amdgcn_sched_barrier(0)
__device__ __forceinline__ int crow(int r, int hi) { return (r & 3) + 8 * (r >> 2) + 4 * hi; }
__device__ __forceinline__ unsigned cvtpk(float lo, float hi) { unsigned r; asm volatile("v_cvt_pk_bf16_f32 %0, %1, %2" : "=v"(r) : "v"(lo), "v"(hi)); return r; }

__device__ __forceinline__ void partialSM(f32x16& p0, f32x16& p1, float& m_reg, float& mn, float& alpha) {
  constexpr float C = SCALE * 1.4426950408889634f;
  float pmax = p0[0];
#pragma unroll
  for (int r = 1; r < 16; ++r) pmax = fmaxf(pmax, p0[r]);
#pragma unroll
  for (int r = 0; r < 16; ++r) pmax = fmaxf(pmax, p1[r]);
  { auto rr = __builtin_amdgcn_permlane32_swap(__float_as_uint(pmax), __float_as_uint(pmax), false, false);
    pmax = fmaxf(__uint_as_float(rr[0]), __uint_as_float(rr[1])); }
  if (__builtin_expect(__all(pmax - m_reg <= THR / SCALE), 1)) { mn = m_reg; alpha = 1.f; }
  else { mn = fmaxf(m_reg, pmax); alpha = __builtin_amdgcn_exp2f((m_reg - mn) * C); m_reg = mn; }
  float mnC = -mn * C;
#pragma unroll
  for (int r = 0; r < 16; ++r) p0[r] = fmaf(p0[r], C, mnC);
#pragma unroll
  for (int r = 0; r < 16; ++r) p1[r] = fmaf(p1[r], C, mnC);
#pragma unroll
  for (int r = 0; r < 16; ++r) p0[r] = __builtin_amdgcn_exp2f(p0[r]);
}
__device__ __forceinline__ void finishSM(f32x16& p0, f32x16& p1, float alpha, float& l_reg, bf16x8& pa0, bf16x8& pa1, bf16x8& pa2, bf16x8& pa3) {
#pragma unroll
  for (int r = 0; r < 16; ++r) p1[r] = __builtin_amdgcn_exp2f(p1[r]);
  float ps = 0;
#pragma unroll
  for (int r = 0; r < 16; ++r) ps += p0[r];
#pragma unroll
  for (int r = 0; r < 16; ++r) ps += p1[r];
  { auto rr = __builtin_amdgcn_permlane32_swap(__float_as_uint(ps), __float_as_uint(ps), false, false);
    ps = __uint_as_float(rr[0]) + __uint_as_float(rr[1]); }
  l_reg = l_reg * alpha + ps;
#define PK4(P, BASE, OUT) do { unsigned a0 = cvtpk(P[BASE + 0], P[BASE + 1]), a1 = cvtpk(P[BASE + 2], P[BASE + 3]);   \
    unsigned b0 = cvtpk(P[BASE + 4], P[BASE + 5]), b1 = cvtpk(P[BASE + 6], P[BASE + 7]);                              \
    auto r0 = __builtin_amdgcn_permlane32_swap(a0, b0, false, false); auto r1 = __builtin_amdgcn_permlane32_swap(a1, b1, false, false); \
    u32x4 w = {r0[0], r1[0], r0[1], r1[1]}; OUT = *reinterpret_cast<bf16x8*>(&w); } while (0)
  PK4(p0, 0, pa0); PK4(p0, 8, pa1); PK4(p1, 0, pa2); PK4(p1, 8, pa3);
#undef PK4
}
__device__ __forceinline__ void qkt(f32x16& p0, f32x16& p1, const bf16* Ks, const bf16x8* qr, int r32, int hi, bool domask, int mbase) {
  if (domask) {
#pragma unroll
    for (int r = 0; r < 16; ++r) { const int c = (r & 3) + 8 * (r >> 2);
      p0[r] = ((unsigned)(mbase + c + 128) <= 256u) ? 0.f : -INFINITY; p1[r] = ((unsigned)(mbase + c + 32 + 128) <= 256u) ? 0.f : -INFINITY; }
  } else { p0 = f32x16{}; p1 = f32x16{}; }
#pragma unroll
  for (int d0 = 0; d0 < 8; ++d0) { int cb = (d0 * 16 + hi * 8) * 2;
    bf16x8 b0 = *reinterpret_cast<const bf16x8*>((const char*)Ks + KSWZ(r32, cb));
    bf16x8 b1 = *reinterpret_cast<const bf16x8*>((const char*)Ks + KSWZ(32 + r32, cb));
    p0 = __builtin_amdgcn_mfma_f32_32x32x16_bf16(b0, qr[d0], p0, 0, 0, 0);
    p1 = __builtin_amdgcn_mfma_f32_32x32x16_bf16(b1, qr[d0], p1, 0, 0, 0); }
}
__device__ __forceinline__ int v_st(int k, int c) { const int kk = (k & ~0xC) | ((k & 4) << 1) | ((k & 8) >> 1); return ((kk >> 3) * 4 + (c >> 5)) * 512 + ((kk & 7) * 32 + (c & 31)) * 2; }
__device__ __forceinline__ int v_rd_base(int lane) { return ((lane & 3) << 3) | (((lane >> 2) & 3) << 6) | (((lane >> 4) & 1) << 5) | (((lane >> 5) & 1) << 8); }
constexpr int v_rd_off(int d0, int ks, int half) { return d0 * 512 + ks * 4096 + half * 2048; }
template <int OFF> __device__ __forceinline__ s16x4 tr_read(int vb) {
  s16x4 r; asm volatile("ds_read_b64_tr_b16 %0, %1 offset:%2" : "=&v"(r) : "v"(vb), "i"(OFF) : "memory"); return r;
}
template <int D0> __device__ __forceinline__ void pv_one(f32x16& od, int vb, bf16x8 pa0, bf16x8 pa1, bf16x8 pa2, bf16x8 pa3) {
  const s16x4 l0 = tr_read<v_rd_off(D0, 0, 0)>(vb), h0 = tr_read<v_rd_off(D0, 0, 1)>(vb), l1 = tr_read<v_rd_off(D0, 1, 0)>(vb), h1 = tr_read<v_rd_off(D0, 1, 1)>(vb);
  const s16x4 l2 = tr_read<v_rd_off(D0, 2, 0)>(vb), h2 = tr_read<v_rd_off(D0, 2, 1)>(vb), l3 = tr_read<v_rd_off(D0, 3, 0)>(vb), h3 = tr_read<v_rd_off(D0, 3, 1)>(vb);
  asm volatile("s_waitcnt lgkmcnt(0)" ::: "memory"); SBAR();
#define PK(L, H) (bf16x8){L[0], L[1], L[2], L[3], H[0], H[1], H[2], H[3]}
  od = __builtin_amdgcn_mfma_f32_32x32x16_bf16(pa0, PK(l0, h0), od, 0, 0, 0);
  od = __builtin_amdgcn_mfma_f32_32x32x16_bf16(pa1, PK(l1, h1), od, 0, 0, 0);
  od = __builtin_amdgcn_mfma_f32_32x32x16_bf16(pa2, PK(l2, h2), od, 0, 0, 0);
  od = __builtin_amdgcn_mfma_f32_32x32x16_bf16(pa3, PK(l3, h3), od, 0, 0, 0);
#undef PK
}
__device__ __forceinline__ void pv_d0(f32x16* o, int vb, bf16x8 pa0, bf16x8 pa1, bf16x8 pa2, bf16x8 pa3) {
  pv_one<0>(o[0], vb, pa0, pa1, pa2, pa3); pv_one<1>(o[1], vb, pa0, pa1, pa2, pa3); pv_one<2>(o[2], vb, pa0, pa1, pa2, pa3); pv_one<3>(o[3], vb, pa0, pa1, pa2, pa3);
}

__device__ __forceinline__ void attn_body(const bf16* __restrict__ Qb, const bf16* __restrict__ Kl, const bf16* __restrict__ Vl, const bf16* __restrict__ Kc, const bf16* __restrict__ Vc,
                                          int NT, int nloc, bool masked, int kp0, int q0, float sink_l2, bf16* __restrict__ Ob, char* lds, int tid) {
  const int wid = tid >> 6, lane = tid & 63, r32 = lane & 31, hi = lane >> 5;
  bf16* V_lds = (bf16*)lds; bf16* K_lds = (bf16*)(lds + 2 * SHM_V);
  float* wsl = (float*)(lds + 2 * SHM_V + 2 * SHM_K) + wid * 64; float* li_l = wsl; float* al_l = wsl + 32;
  float m_reg = -1e30f, l_reg = 0; f32x16 o[4] = {}; bf16x8 qr[8];
  const bf16* Qw = Qb + (long)(wid * QBLK + r32) * LDQ + hi * 8;
#pragma unroll
  for (int d0 = 0; d0 < 8; ++d0) qr[d0] = *reinterpret_cast<const bf16x8*>(Qw + d0 * 16);
  const int sr = tid >> 4, sc = (tid & 15) * 8, vst0 = v_st(sr, sc), vst1 = v_st(32 + sr, sc);
  const int vb0 = (int)(uintptr_t)V_lds + v_rd_base(lane);
  const int mb0 = kp0 - (q0 + wid * QBLK + r32) + 4 * hi;
  struct { bf16x8 vs0, vs1, ks0, ks1; } sr_[2];
#define TILEK(j) ((j) < nloc ? Kl + (long)(j) * (KVBLK * LDK) : Kc + (long)((j) - nloc) * (KVBLK * LDK))
#define TILEV(j) ((j) < nloc ? Vl + (long)(j) * (KVBLK * LDK) : Vc + (long)((j) - nloc) * (KVBLK * LDK))
#define SLOAD(i, j) do { const bf16* kt_ = TILEK(j); const bf16* vt_ = TILEV(j); \
    sr_[i].vs0 = *reinterpret_cast<const bf16x8*>(&vt_[(long)(sr) * LDK + sc]); sr_[i].vs1 = *reinterpret_cast<const bf16x8*>(&vt_[(long)(32 + sr) * LDK + sc]); \
    sr_[i].ks0 = *reinterpret_cast<const bf16x8*>(&kt_[(long)(sr) * LDK + sc]); sr_[i].ks1 = *reinterpret_cast<const bf16x8*>(&kt_[(long)(32 + sr) * LDK + sc]); } while (0)
#define SWRITE(b, i) do { *(bf16x8*)((char*)V_lds + (b) * SHM_V + vst0) = sr_[i].vs0;          \
    *(bf16x8*)((char*)V_lds + (b) * SHM_V + vst1) = sr_[i].vs1; int kc = sc * 2;               \
    *(bf16x8*)((char*)K_lds + (b) * SHM_K + KSWZ(sr, kc)) = sr_[i].ks0;                       \
    *(bf16x8*)((char*)K_lds + (b) * SHM_K + KSWZ(32 + sr, kc)) = sr_[i].ks1; } while (0)
#define SWAIT() asm volatile("s_waitcnt vmcnt(4)" ::: "memory")
#define RESC(a) do { if (__any((a) < 1.f)) { if (hi == 0) al_l[r32] = (a); asm volatile("s_waitcnt lgkmcnt(0)" ::: "memory"); \
    _Pragma("unroll") for (int d = 0; d < 4; ++d) _Pragma("unroll") for (int r = 0; r < 16; ++r) o[d][r] *= al_l[crow(r, hi)]; } } while (0)
#define QKT(P0, P1, KS, j) qkt(P0, P1, KS, qr, r32, hi, masked && (j) < nloc, mb0 + 64 * (j))
  f32x16 pA0, pA1, pB0, pB1; float mnA, mnB, alA, alB; bf16x8 pa0, pa1, pa2, pa3;
  constexpr int SE = 0, SO = 1;
  SLOAD(SE, 0); asm volatile("s_waitcnt vmcnt(0)" ::: "memory"); SWRITE(0, SE); __syncthreads();
  QKT(pA0, pA1, K_lds, 0); partialSM(pA0, pA1, m_reg, mnA, alA);
  SLOAD(SO, 1); if (2 < NT) SLOAD(SE, 2);
  SWAIT(); SWRITE(1, SO); __syncthreads();
  for (int j = 1; j + 1 < NT; j += 2) {
    SBAR(); QKT(pB0, pB1, (bf16*)((char*)K_lds + SHM_K), j);
    finishSM(pA0, pA1, alA, l_reg, pa0, pa1, pa2, pa3); SBAR();
    SLOAD(SO, (j + 2 < NT ? j + 2 : NT - 1)); SBAR();
    pv_d0(o, vb0, pa0, pa1, pa2, pa3); partialSM(pB0, pB1, m_reg, mnB, alB);
    __syncthreads(); SWAIT(); SWRITE(0, SE);
    RESC(alB); __syncthreads();
    SBAR(); QKT(pA0, pA1, K_lds, j + 1);
    finishSM(pB0, pB1, alB, l_reg, pa0, pa1, pa2, pa3); SBAR();
    if (j + 3 < NT) SLOAD(SE, j + 3); SBAR();
    pv_d0(o, vb0 + (int)SHM_V, pa0, pa1, pa2, pa3); partialSM(pA0, pA1, m_reg, mnA, alA);
    __syncthreads(); SWAIT(); SWRITE(1, SO);
    RESC(alA); __syncthreads();
  }
  SBAR(); QKT(pB0, pB1, (bf16*)((char*)K_lds + SHM_K), NT - 1);
  finishSM(pA0, pA1, alA, l_reg, pa0, pa1, pa2, pa3); SBAR();
  pv_d0(o, vb0, pa0, pa1, pa2, pa3); partialSM(pB0, pB1, m_reg, mnB, alB);
  __syncthreads(); RESC(alB);
  finishSM(pB0, pB1, alB, l_reg, pa0, pa1, pa2, pa3); SBAR();
  pv_d0(o, vb0 + (int)SHM_V, pa0, pa1, pa2, pa3);
  l_reg += __builtin_amdgcn_exp2f(sink_l2 - m_reg * (SCALE * 1.4426950408889634f));
  if (hi == 0) li_l[r32] = l_reg; asm volatile("s_waitcnt lgkmcnt(0)" ::: "memory");
  float rli[16];
#pragma unroll
  for (int r = 0; r < 16; ++r) rli[r] = __builtin_amdgcn_rcpf(li_l[crow(r, hi)]);
  bf16* Ow = Ob + (long)(wid * QBLK) * LDO;
#pragma unroll
  for (int r = 0; r < 16; ++r) { int orow = crow(r, hi);
#pragma unroll
    for (int d0 = 0; d0 < 4; ++d0) { const float ov = o[d0][r] * rli[r]; Ow[(long)orow * LDO + d0 * 32 + r32] = (bf16)cvtpk(ov, ov); } }
  __syncthreads();
#undef TILEK
#undef TILEV
#undef SLOAD
#undef SWRITE
#undef SWAIT
#undef RESC
#undef QKT
}
#undef KSWZ
#undef SBAR
}

#ifndef EN_ALL
#define EN_ALL 1
#endif
#ifndef EN_P0
#define EN_P0 EN_ALL
#endif
#ifndef EN_MOD0
#define EN_MOD0 EN_ALL
#endif
#ifndef EN_G1
#define EN_G1 EN_ALL
#endif
#ifndef EN_ROPE
#define EN_ROPE EN_ALL
#endif
#ifndef EN_HGRN
#define EN_HGRN EN_ALL
#endif
#ifndef EN_ATT
#define EN_ATT EN_ALL
#endif
#ifndef EN_MIX
#define EN_MIX EN_ALL
#endif
#ifndef EN_G3
#define EN_G3 EN_ALL
#endif
#ifndef EN_LN
#define EN_LN EN_ALL
#endif
#ifndef EN_G5
#define EN_G5 EN_ALL
#endif
#ifndef EN_G6
#define EN_G6 EN_ALL
#endif
constexpr int DM = 2048, NPR = 8192, NSR = 2048, MT = 10240, IN_DIM = 6656, DFF = 8192;
constexpr float LN_EPS = 1e-5f, RMS_EPS = 1e-6f, DN_ALPHA = 1.681792830507429f, ATT_SCALE = 0.08838834764831845f;
constexpr size_t OUT_CK = 20971520, OUT_CV = 29360128, OUT_SF = 37748736, OUT_SB = 54525952;
constexpr size_t MiB = 1u << 20;
constexpr size_t WS_CTL = 0, CTL_ZERO_BYTES = 1 * MiB;
constexpr size_t WS_ROPE = 1 * MiB, WS_LB = 1 * MiB + 65536, WS_MODS = 2 * MiB;
constexpr size_t WS_WIN = 4 * MiB, WS_WO = 108 * MiB, WS_WUP = 140 * MiB, WS_WDN = 268 * MiB;
constexpr size_t WS_X = 396 * MiB, WS_Y = 476 * MiB, WS_H = 556 * MiB, WS_MIX = 596 * MiB, WS_ACT = 636 * MiB;
constexpr size_t WS_QB = 796 * MiB, WS_KB = 816 * MiB, WS_VB = 821 * MiB, WS_HQ = 826 * MiB, WS_HI = 846 * MiB, WS_HG = 866 * MiB;
constexpr size_t WS_ZF = 886 * MiB, WS_ZB = 926 * MiB, WS_OF = 966 * MiB, WS_OB = 1006 * MiB, WS_ATT = 1046 * MiB, WS_CKB = 1086 * MiB, WS_CVB = 1088 * MiB, WS_SL = 1090 * MiB, WS_END = 1250 * MiB;
constexpr int CW_BAR = 4096, CW_Q = 16384;
constexpr int RING_BYTES = 131072, LDS_BYTES = 163840, LDSCTL_OFF = LDS_BYTES - 512, MISC_OFF = LDSCTL_OFF + 320;

#define GAS __attribute__((address_space(1)))
#define LAS __attribute__((address_space(3)))
typedef unsigned short bf16;
typedef unsigned v4u __attribute__((ext_vector_type(4)));
typedef unsigned v2u __attribute__((ext_vector_type(2)));
typedef float f32x4 __attribute__((ext_vector_type(4)));
typedef float f32x2 __attribute__((ext_vector_type(2)));
typedef GAS unsigned gu32;
#define LDS_WAIT() asm volatile("s_waitcnt lgkmcnt(0)" ::: "memory")
__device__ __forceinline__ unsigned f2bf(float f) { unsigned u = __builtin_bit_cast(unsigned, f); return (u + 0x7fffu + ((u >> 16) & 1u)) >> 16; }
__device__ __forceinline__ unsigned pk2(float lo, float hi) { return f2bf(lo) | (f2bf(hi) << 16); }
__device__ __forceinline__ float bflo(unsigned w) { return __builtin_bit_cast(float, w << 16); }
__device__ __forceinline__ float bfhi(unsigned w) { return __builtin_bit_cast(float, w & 0xffff0000u); }
__device__ __forceinline__ float bf2f(bf16 b) { return __builtin_bit_cast(float, ((unsigned)b) << 16); }
__device__ __forceinline__ float siluf(float x) { return x * __builtin_amdgcn_rcpf(1.f + __expf(-x)); }


namespace hg {
typedef unsigned short bf16;
using bf16x8 = __attribute__((ext_vector_type(8))) short;
using bf16x4 = __attribute__((ext_vector_type(4))) short;
using f32x16 = __attribute__((ext_vector_type(16))) float;
constexpr int QS = 136, TS = 40;
constexpr int OFF_QT = 0, OFF_KT = 8704, OFF_KTT = 17408, OFF_EMID = 27648, OFF_ELM = 28160, OFF_VT = 28672, VT_BYTES = 2560, BUF_BYTES = 38912;
constexpr int HG_LDS_BYTES = 4 * BUF_BYTES;
__device__ __forceinline__ int crow(int r, int hi) { return (r & 3) + 8 * (r >> 2) + 4 * hi; }
__device__ __forceinline__ unsigned cvtpk(float lo, float hi) { unsigned r; asm volatile("v_cvt_pk_bf16_f32 %0, %1, %2" : "=v"(r) : "v"(lo), "v"(hi)); return r; }
__device__ __forceinline__ unsigned f2bfc(float f) { unsigned u = __builtin_bit_cast(unsigned, f); return (u + 0x7fffu + ((u >> 16) & 1u)) >> 16; }
__device__ __forceinline__ unsigned pk2c(float lo, float hi) { return f2bfc(lo) | (f2bfc(hi) << 16); }
__device__ __forceinline__ bf16x8 pack8(const f32x16& x, int b) {
  typedef unsigned u32x4 __attribute__((ext_vector_type(4)));
  u32x4 w = {cvtpk(x[b + 0], x[b + 1]), cvtpk(x[b + 2], x[b + 3]), cvtpk(x[b + 4], x[b + 5]), cvtpk(x[b + 6], x[b + 7])}; return __builtin_bit_cast(bf16x8, w);
}
__device__ __forceinline__ bf16x8 cat4(bf16x4 a, bf16x4 b) { return (bf16x8){a[0], a[1], a[2], a[3], b[0], b[1], b[2], b[3]}; }

__device__ __forceinline__ void gates_to_lds(LAS unsigned char* buf, const float (&zr)[16], const bf16 (&qr)[16], bf16x8 va, bf16x8 vb, float lbv, float olb, int dkg, int half, int js, int r32, int hi) {
  LAS bf16* Qt = (LAS bf16*)(buf + OFF_QT); LAS bf16* Kt = (LAS bf16*)(buf + OFF_KT); LAS bf16* KtT = (LAS bf16*)(buf + OFF_KTT);
  LAS float* emid = (LAS float*)(buf + OFF_EMID); LAS float* elm = (LAS float*)(buf + OFF_ELM); LAS bf16* Vt = (LAS bf16*)(buf + OFF_VT + js * VT_BYTES);
  float fz[16], kz[16], qv[16];
#pragma unroll
  for (int ii = 0; ii < 16; ++ii) { const float z = zr[ii]; qv[ii] = __builtin_bit_cast(float, ((unsigned)qr[ii]) << 16);
    const float e = __expf(-fmaxf(z, -80.f)), rr = __builtin_amdgcn_rcpf(1.f + e); fz[ii] = (1.f + lbv * e) * rr; kz[ii] = olb * e * rr; }
  unsigned kw[8];
  if (half) { float E = 1.f;
#pragma unroll
    for (int ii = 0; ii < 16; ++ii) { E = fmaxf(E * fz[ii], 1e-30f); const float qt = qv[ii] * E, kt = kz[ii] * __builtin_amdgcn_rcpf(E);
      const unsigned qb = cvtpk(qt, qt), kb = cvtpk(kt, kt); Qt[(16 + ii) * QS + dkg] = (bf16)qb; Kt[(16 + ii) * QS + dkg] = (bf16)kb;
      if (ii & 1) kw[ii >> 1] |= kb << 16; else kw[ii >> 1] = kb & 0xffffu; }
    elm[dkg] = E;
  } else { float Dd = 1.f;
#pragma unroll
    for (int ii = 15; ii >= 0; --ii) { const float qt = qv[ii] * __builtin_amdgcn_rcpf(Dd), kt = kz[ii] * Dd;
      const unsigned qb = cvtpk(qt, qt), kb = cvtpk(kt, kt); Qt[ii * QS + dkg] = (bf16)qb; Kt[ii * QS + dkg] = (bf16)kb;
      if (ii & 1) kw[ii >> 1] = kb << 16; else kw[ii >> 1] |= kb & 0xffffu;
      Dd = fmaxf(Dd * fz[ii], 1e-30f); }
    emid[dkg] = Dd;
  }
  typedef unsigned u32x4 __attribute__((ext_vector_type(4)));
  LAS u32x4* kd = (LAS u32x4*)(KtT + dkg * TS + 16 * half);
  kd[0] = (u32x4){kw[0], kw[1], kw[2], kw[3]}; kd[1] = (u32x4){kw[4], kw[5], kw[6], kw[7]};
#pragma unroll
  for (int e = 0; e < 8; ++e) { Vt[(16 * hi + e) * TS + r32] = (bf16)va[e]; Vt[(16 * hi + 8 + e) * TS + r32] = (bf16)vb[e]; }
}

__device__ __forceinline__ f32x16 chunk_mfma(LAS unsigned char* buf, f32x16 (&S)[4], int js, int r32, int hi) {
  const LAS bf16* Qt = (const LAS bf16*)(buf + OFF_QT); const LAS bf16* Kt = (const LAS bf16*)(buf + OFF_KT); const LAS bf16* KtT = (const LAS bf16*)(buf + OFF_KTT);
  const LAS float* emid = (const LAS float*)(buf + OFF_EMID); const LAS float* elm = (const LAS float*)(buf + OFF_ELM); const LAS bf16* Vt = (const LAS bf16*)(buf + OFF_VT + js * VT_BYTES);
  bf16x8 Sb[4][2];
#pragma unroll
  for (int Tt = 0; Tt < 4; ++Tt) {
#pragma unroll
    for (int qd = 0; qd < 4; ++qd) { const f32x4 em = *(const LAS f32x4*)(emid + 32 * Tt + 8 * qd + 4 * hi);
#pragma unroll
      for (int e = 0; e < 4; ++e) S[Tt][4 * qd + e] *= em[e]; }
    Sb[Tt][0] = pack8(S[Tt], 0); Sb[Tt][1] = pack8(S[Tt], 8); }
  f32x16 AT = {}, oT = {};
#pragma unroll
  for (int hb = 0; hb < 2; ++hb) { bf16x8 ka[4], qb[4], qp[2][2];
#pragma unroll
    for (int st = 0; st < 4; ++st) { ka[st] = *(const LAS bf16x8*)(Kt + r32 * QS + 16 * (4 * hb + st) + 8 * hi); qb[st] = *(const LAS bf16x8*)(Qt + r32 * QS + 16 * (4 * hb + st) + 8 * hi); }
#pragma unroll
    for (int t2 = 0; t2 < 2; ++t2)
#pragma unroll
      for (int s2 = 0; s2 < 2; ++s2) { const LAS bf16* qr = Qt + r32 * QS + 32 * (2 * hb + t2) + 16 * s2 + 4 * hi; qp[t2][s2] = cat4(*(const LAS bf16x4*)(qr), *(const LAS bf16x4*)(qr + 8)); }
#pragma unroll
    for (int j = 0; j < 4; ++j) { AT = __builtin_amdgcn_mfma_f32_32x32x16_bf16(ka[j], qb[j], AT, 0, 0, 0);
      oT = __builtin_amdgcn_mfma_f32_32x32x16_bf16(Sb[2 * hb + (j >> 1)][j & 1], qp[j >> 1][j & 1], oT, 0, 0, 0); } }
  { const bf16x8 v0 = *(const LAS bf16x8*)(Vt + r32 * TS + 8 * hi), v1 = *(const LAS bf16x8*)(Vt + r32 * TS + 16 + 8 * hi);
    bf16x8 kf[4][2];
#pragma unroll
    for (int Tt = 0; Tt < 4; ++Tt) { const LAS bf16* kr = KtT + (32 * Tt + r32) * TS + 8 * hi; kf[Tt][0] = *(const LAS bf16x8*)(kr); kf[Tt][1] = *(const LAS bf16x8*)(kr + 16); }
#pragma unroll
    for (int Tt = 0; Tt < 4; ++Tt) S[Tt] = __builtin_amdgcn_mfma_f32_32x32x16_bf16(kf[Tt][0], v0, S[Tt], 0, 0, 0);
#pragma unroll
    for (int Tt = 0; Tt < 4; ++Tt) S[Tt] = __builtin_amdgcn_mfma_f32_32x32x16_bf16(kf[Tt][1], v1, S[Tt], 0, 0, 0); }
#pragma unroll
  for (int r = 0; r < 16; ++r) AT[r] = (crow(r, hi) <= r32) ? AT[r] : 0.f;
  { const bf16x8 Pb0 = pack8(AT, 0), Pb1 = pack8(AT, 8); const LAS bf16* vr = Vt + r32 * TS + 4 * hi;
    const bf16x8 v0 = cat4(*(const LAS bf16x4*)(vr), *(const LAS bf16x4*)(vr + 8)), v1 = cat4(*(const LAS bf16x4*)(vr + 16), *(const LAS bf16x4*)(vr + 24));
    oT = __builtin_amdgcn_mfma_f32_32x32x16_bf16(v0, Pb0, oT, 0, 0, 0);
    oT = __builtin_amdgcn_mfma_f32_32x32x16_bf16(v1, Pb1, oT, 0, 0, 0); }
#pragma unroll
  for (int Tt = 0; Tt < 4; ++Tt)
#pragma unroll
    for (int qd = 0; qd < 4; ++qd) { const f32x4 el = *(const LAS f32x4*)(elm + 32 * Tt + 8 * qd + 4 * hi);
#pragma unroll
      for (int e = 0; e < 4; ++e) S[Tt][4 * qd + e] *= el[e]; }
  return oT;
}

__device__ __forceinline__ void store_state(float* __restrict__ s_out, const f32x16 (&S)[4], int js, int r32, int hi) {
  int lo = (4 * hi) * 128 + 32 * js + r32; asm volatile("" : "+v"(lo));
  float* p = s_out + lo;
#pragma unroll
  for (int Tt = 0; Tt < 4; ++Tt)
#pragma unroll
    for (int r = 0; r < 16; ++r) p[(32 * Tt + (r & 3) + 8 * (r >> 2)) * 128] = S[Tt][r];
}
__device__ __forceinline__ void hgrn_body(LAS unsigned char* base, int tid, int wave, const float* __restrict__ Z, const bf16* __restrict__ HQ, const bf16* __restrict__ HI,
                                          bf16* __restrict__ O, const float* __restrict__ lb, const float* __restrict__ s_in, float* __restrict__ s_out, int row0, int T, int hcol, int dir) {
  const int lane = tid & 63, role = wave >> 2, js = wave & 3, r32 = lane & 31, hi = lane >> 5;
  const int nch = T >> 5;
#define HG_BAR() asm volatile("s_waitcnt lgkmcnt(0)\n\ts_barrier" ::: "memory")
  if (role) {
    const int lt = tid & 255, dkg = lt & 127, half = (wave >> 1) & 1;
    const float lbv = lb[dkg], olb = 1.f - lbv;
    float zr[16]; bf16 qr[16]; bf16x8 va, vb;
#define HG_LOAD(nn) do { _Pragma("unroll") for (int ii = 0; ii < 16; ++ii) { const int i_ = 32 * (nn) + 16 * half + ii, t_ = dir ? T - 1 - i_ : i_; const size_t off_ = (size_t)(row0 + t_) * 1024 + hcol + dkg; \
      zr[ii] = Z[off_]; qr[ii] = HQ[off_]; } \
    { const int i_ = 32 * (nn) + r32, t_ = dir ? T - 1 - i_ : i_; const bf16* src_ = HI + (size_t)(row0 + t_) * 1024 + hcol + 32 * js + 16 * hi; va = *(const bf16x8*)src_; vb = *(const bf16x8*)(src_ + 8); } } while (0)
    HG_LOAD(0);
    gates_to_lds(base, zr, qr, va, vb, lbv, olb, dkg, half, js, r32, hi);
    HG_LOAD(nch > 1 ? 1 : 0);
    HG_BAR();
    for (int n = 0; n < nch; ++n) {
      if (n + 1 < nch) gates_to_lds(base + ((n + 1) & 1) * BUF_BYTES, zr, qr, va, vb, lbv, olb, dkg, half, js, r32, hi);
      { const int nn = n + 2 < nch ? n + 2 : nch - 1; HG_LOAD(nn); }
      HG_BAR();
    }
#undef HG_LOAD
  } else {
    f32x16 S[4];
#pragma unroll
    for (int Tt = 0; Tt < 4; ++Tt)
#pragma unroll
      for (int r = 0; r < 16; ++r) S[Tt][r] = s_in ? s_in[(size_t)(32 * Tt + crow(r, hi)) * 128 + 32 * js + r32] : 0.f;
    HG_BAR();
    for (int n = 0; n < nch; ++n) {
      const f32x16 oT = chunk_mfma(base + (n & 1) * BUF_BYTES, S, js, r32, hi);
      { const int i = 32 * n + r32, t = dir ? T - 1 - i : i; bf16* op = O + (size_t)(row0 + t) * 1024 + hcol + 32 * js + 4 * hi; typedef unsigned u32x2_t __attribute__((ext_vector_type(2)));
#pragma unroll
        for (int qd = 0; qd < 4; ++qd) { u32x2_t w; w.x = pk2c(oT[4 * qd], oT[4 * qd + 1]); w.y = pk2c(oT[4 * qd + 2], oT[4 * qd + 3]);     *(u32x2_t*)(op + 8 * qd) = w; } }
      HG_BAR();
    }
    if (s_out) {
#pragma unroll
      for (int Tt = 0; Tt < 4; ++Tt)
#pragma unroll
        for (int r = 0; r < 16; ++r) s_out[(size_t)(32 * Tt + crow(r, hi)) * 128 + 32 * js + r32] = S[Tt][r];
    }
  }
#undef HG_BAR
}

constexpr int OFL_OFF = 2 * BUF_BYTES, OFL_STRIDE = 136, SSL_OFF = OFL_OFF + 256 * OFL_STRIDE * 2;
__device__ __forceinline__ void hgrn_dual(LAS unsigned char* base, int tid, int wave, const float* __restrict__ Zf, const float* __restrict__ Zb, const bf16* __restrict__ HQ, const bf16* __restrict__ HI,
                                          const bf16* __restrict__ HGt, bf16* __restrict__ MIXo, const float* __restrict__ lbf, const float* __restrict__ lbb, const float* __restrict__ gnorm,
                                          float* __restrict__ sf_out, float* __restrict__ sb_out, int row0, int hcol) {
  constexpr int T = 256, nch = 8;
  const int lane = tid & 63, role = wave >> 2, js = wave & 3, r32 = lane & 31, hi = lane >> 5;
  LAS bf16* OFL = (LAS bf16*)(base + OFL_OFF); LAS float* SSL = (LAS float*)(base + SSL_OFF);
#define HG_BAR() asm volatile("s_waitcnt lgkmcnt(0)\n\ts_barrier" ::: "memory")
  if (role) {
    const int lt = tid & 255, dkg = lt & 127, half = (wave >> 1) & 1;
    float zr[16]; bf16 qr[16]; bf16x8 va, vb;
#pragma unroll 1
    for (int dir = 0; dir < 2; ++dir) {
      const float* Z = dir ? Zb : Zf; const float lbv = (dir ? lbb : lbf)[dkg], olb = 1.f - lbv;
#define HG_LOAD(nn) do { _Pragma("unroll") for (int ii = 0; ii < 16; ++ii) { const int i_ = 32 * (nn) + 16 * half + ii, t_ = dir ? T - 1 - i_ : i_; const size_t off_ = (size_t)(row0 + t_) * 1024 + hcol + dkg; \
      zr[ii] = Z[off_]; qr[ii] = HQ[off_]; } \
    { const int i_ = 32 * (nn) + r32, t_ = dir ? T - 1 - i_ : i_; const bf16* src_ = HI + (size_t)(row0 + t_) * 1024 + hcol + 32 * js + 16 * hi; va = *(const bf16x8*)src_; vb = *(const bf16x8*)(src_ + 8); } } while (0)
      HG_LOAD(0);
      gates_to_lds(base, zr, qr, va, vb, lbv, olb, dkg, half, js, r32, hi);
      HG_LOAD(1);
      HG_BAR();
#pragma unroll 1
      for (int n = 0; n < nch; ++n) {
        if (n + 1 < nch) gates_to_lds(base + ((n + 1) & 1) * BUF_BYTES, zr, qr, va, vb, lbv, olb, dkg, half, js, r32, hi);
        { const int nn = n + 2 < nch ? n + 2 : nch - 1; HG_LOAD(nn); }
        HG_BAR();
      }
#undef HG_LOAD
    }
    HG_BAR();
  } else {
    typedef unsigned u32x2_t __attribute__((ext_vector_type(2)));
    f32x16 S[4];
#pragma unroll
    for (int Tt = 0; Tt < 4; ++Tt)
#pragma unroll
      for (int r = 0; r < 16; ++r) S[Tt][r] = 0.f;
    HG_BAR();
#pragma unroll 1
    for (int n = 0; n < nch; ++n) {
      const f32x16 oT = chunk_mfma(base + (n & 1) * BUF_BYTES, S, js, r32, hi);
      { LAS bf16* op = OFL + (32 * n + r32) * OFL_STRIDE + 32 * js + 4 * hi;
#pragma unroll
        for (int qd = 0; qd < 4; ++qd) { u32x2_t w; w.x = pk2c(oT[4 * qd], oT[4 * qd + 1]); w.y = pk2c(oT[4 * qd + 2], oT[4 * qd + 3]); *(LAS u32x2_t*)(op + 8 * qd) = w; } }
      HG_BAR();
    }
    store_state(sf_out, S, js, r32, hi);
#pragma unroll
    for (int Tt = 0; Tt < 4; ++Tt)
#pragma unroll
      for (int r = 0; r < 16; ++r) S[Tt][r] = 0.f;
    unsigned opk[8] = {0u, 0u, 0u, 0u, 0u, 0u, 0u, 0u};
    HG_BAR();
#pragma unroll 1
    for (int n = 0; n <= nch; ++n) {
      if (n > 0) {
        const int m = n - 1; const LAS float* sp = SSL + ((m & 1) * 4) * 32 + r32; const float tot = (sp[0] + sp[32]) + (sp[64] + sp[96]);
        const float rs = 1.f / sqrtf(tot * (1.f / 128.f) + 1e-6f);
        const int t = T - 1 - (32 * m + r32); const size_t go = (size_t)(row0 + t) * 1024 + hcol + 32 * js + 4 * hi; bf16* mo = MIXo + (size_t)(row0 + t) * 2048 + 1024 + hcol + 32 * js + 4 * hi;
#pragma unroll
        for (int qd = 0; qd < 4; ++qd) { const u32x2_t gw = *(const u32x2_t*)(HGt + go + 8 * qd); const f32x4 gq = *(const f32x4*)(gnorm + 32 * js + 8 * qd + 4 * hi);
          const float y0 = __builtin_bit_cast(float, opk[2 * qd] << 16) * rs * gq[0] * __builtin_bit_cast(float, gw.x << 16), y1 = __builtin_bit_cast(float, opk[2 * qd] & 0xffff0000u) * rs * gq[1] * __builtin_bit_cast(float, gw.x & 0xffff0000u);
          const float y2 = __builtin_bit_cast(float, opk[2 * qd + 1] << 16) * rs * gq[2] * __builtin_bit_cast(float, gw.y << 16), y3 = __builtin_bit_cast(float, opk[2 * qd + 1] & 0xffff0000u) * rs * gq[3] * __builtin_bit_cast(float, gw.y & 0xffff0000u);
          u32x2_t w; w.x = pk2c(y0, y1); w.y = pk2c(y2, y3); *(u32x2_t*)(mo + 8 * qd) = w; }
      }
      if (n < nch) {
        f32x16 o = chunk_mfma(base + (n & 1) * BUF_BYTES, S, js, r32, hi);
        const int t = T - 1 - (32 * n + r32); const LAS bf16* fp = OFL + t * OFL_STRIDE + 32 * js + 4 * hi; float ss = 0.f;
#pragma unroll
        for (int qd = 0; qd < 4; ++qd) { const u32x2_t w = *(const LAS u32x2_t*)(fp + 8 * qd);
          o[4 * qd] += __builtin_bit_cast(float, w.x << 16); o[4 * qd + 1] += __builtin_bit_cast(float, w.x & 0xffff0000u); o[4 * qd + 2] += __builtin_bit_cast(float, w.y << 16); o[4 * qd + 3] += __builtin_bit_cast(float, w.y & 0xffff0000u);
          opk[2 * qd] = pk2c(o[4 * qd], o[4 * qd + 1]); opk[2 * qd + 1] = pk2c(o[4 * qd + 2], o[4 * qd + 3]);
          const float b0 = __builtin_bit_cast(float, opk[2 * qd] << 16), b1 = __builtin_bit_cast(float, opk[2 * qd] & 0xffff0000u), b2 = __builtin_bit_cast(float, opk[2 * qd + 1] << 16), b3 = __builtin_bit_cast(float, opk[2 * qd + 1] & 0xffff0000u);
          ss += (b0 * b0 + b1 * b1) + (b2 * b2 + b3 * b3); }
        ss += __shfl_xor(ss, 32);
        if (hi == 0) SSL[((n & 1) * 4 + js) * 32 + r32] = ss;
      }
      HG_BAR();
    }
    store_state(sb_out, S, js, r32, hi);
  }
#undef HG_BAR
}
}
#define XB_TMO      128
#define XB_XCNT(j)  (256  + 64 * (j))
#define XB_XSUB(j)  (1280 + 64 * (j))
#define XB_XGEN(j)  (2304 + 64 * (j))
#define XB_TOP      3328
#define XB_TOPGEN   3392
#define XCD_BAR_WORDS 3456
#define XB_SPIN_CAP (1u << 18)
__device__ __forceinline__ unsigned xb_ld(unsigned* p)              { return __hip_atomic_load(p, __ATOMIC_RELAXED, __HIP_MEMORY_SCOPE_AGENT); }
__device__ __forceinline__ unsigned xb_add(unsigned* p, unsigned v) { return __hip_atomic_fetch_add(p, v, __ATOMIC_RELAXED, __HIP_MEMORY_SCOPE_AGENT); }
__device__ __forceinline__ unsigned xb_xcc_id() { return (unsigned)__builtin_amdgcn_s_getreg((3 << 11) | 20) & 0xFu; }
#define XB_SPIN(cond, bar) do { unsigned _sp = 0; while (cond) { __builtin_amdgcn_s_sleep(1); \
    if ((++_sp & 255u) == 0u) { if (xb_ld(&(bar)[XB_TMO])) break; if (_sp > XB_SPIN_CAP) { atomicAdd(&(bar)[XB_TMO], 1u); break; } } } } while (0)
struct XcdBarrier { unsigned* bar; unsigned x; volatile LAS unsigned* st; };
__device__ __forceinline__ XcdBarrier xcd_barrier_post(unsigned* bar, volatile LAS unsigned* st) {
    XcdBarrier b; b.bar = bar; b.x = xb_xcc_id(); b.st = st;
    if (threadIdx.x == 0) (void)xb_add(&bar[XB_XCNT(b.x)], 1u);
    return b;
}
__device__ __forceinline__ void xcd_barrier_complete(unsigned* bar, unsigned x, unsigned& nloc, unsigned& nx) {
    const unsigned G = gridDim.x * gridDim.y * gridDim.z;
    unsigned sum, cnt, mine, sp = 0u;
    for (;;) {
        sum = 0u; cnt = 0u; mine = 0u;
#pragma unroll
        for (unsigned j = 0; j < 16; ++j) { const unsigned c = xb_ld(&bar[XB_XCNT(j)]); sum += c; cnt += (c > 0u) ? 1u : 0u; mine = (j == x) ? c : mine; }
        if (sum == G) break;
        __builtin_amdgcn_s_sleep(1);
        if ((++sp & 255u) == 0u) { if (xb_ld(&bar[XB_TMO])) break; if (sp > XB_SPIN_CAP) { atomicAdd(&bar[XB_TMO], 1u); break; } }
    }
    nloc = mine > 0u ? mine : 1u; nx = cnt > 0u ? cnt : 1u;
}
__device__ __forceinline__ void xcd_barrier(const XcdBarrier& b) {
    asm volatile("s_waitcnt vmcnt(0)" ::: "memory");
    __syncthreads();
    if (threadIdx.x == 0) {
        unsigned* bar = b.bar;
        __builtin_amdgcn_s_waitcnt(0);
        unsigned nloc = b.st[0], nx = b.st[1];
        if (nloc == 0u) { xcd_barrier_complete(bar, b.x, nloc, nx); b.st[0] = nloc; b.st[1] = nx; }
        const unsigned old = xb_add(&bar[XB_XSUB(b.x)], 1u);
        const unsigned gen = old / nloc;
        if (old + 1u == (gen + 1u) * nloc) {
            __builtin_amdgcn_fence(__ATOMIC_RELEASE, "agent");
            asm volatile("s_waitcnt vmcnt(0)" ::: "memory");
            const unsigned og = xb_add(&bar[XB_TOP], 1u);
            const unsigned tg = og / nx;
            if (og + 1u == (tg + 1u) * nx) xb_add(&bar[XB_TOPGEN], 1u);
            else XB_SPIN(xb_ld(&bar[XB_TOPGEN]) == tg, bar);
            __builtin_amdgcn_fence(__ATOMIC_ACQUIRE, "agent");
            xb_add(&bar[XB_XGEN(b.x)], 1u);
            asm volatile("s_waitcnt vmcnt(0)" ::: "memory");
        } else {
            XB_SPIN(xb_ld(&bar[XB_XGEN(b.x)]) == gen, bar);
            __builtin_amdgcn_fence(__ATOMIC_ACQUIRE, "agent");
            asm volatile("s_waitcnt vmcnt(0)" ::: "memory");
        }
    }
    __syncthreads();
}

struct Args { const float* in[20]; float* out; unsigned char* ws; };
typedef const __attribute__((address_space(4))) Args* KArgs;
#define GIN(i) ((const float*)(const GAS float*)(A->in[i]))
struct Frame { LAS unsigned char* lds; unsigned* ctl; unsigned char* ws; float* out; int tid, lane, wave, vcu, G; };

__device__ __forceinline__ float wave_sum(float v) {
#pragma unroll
    for (int o = 1; o < 64; o <<= 1) v += __shfl_xor(v, o);
    return v;
}
__device__ __forceinline__ float wave_max(float v) {
#pragma unroll
    for (int o = 1; o < 64; o <<= 1) v = fmaxf(v, __shfl_xor(v, o));
    return v;
}

__host__ __device__ __forceinline__ int rope_col(int d) { return (d & 64) | ((d & 31) << 1) | ((d >> 5) & 1); }
template <bool QKPERM>
__device__ __forceinline__ void p0_transpose_item(const float* W, int K, int N, bf16* WT, LAS float* scr, int item, int lane) {
    const int nblk = N / 32, kb = item / nblk, nb = item % nblk, k0 = 64 * kb, n0 = 32 * nb;
    float v[32];
#pragma unroll
    for (int i = 0; i < 32; ++i) { const int kk = 2 * i + (lane >> 5); v[i] = W[(size_t)(k0 + kk) * N + n0 + (lane & 31)]; }
#pragma unroll
    for (int i = 0; i < 32; ++i) { const int kk = 2 * i + (lane >> 5); scr[kk * 33 + (lane & 31)] = v[i]; }
    LDS_WAIT(); asm volatile("" ::: "memory");
    const int c = lane & 7;
#pragma unroll
    for (int j = 0; j < 4; ++j) { const int n = (lane >> 3) + 8 * j; const LAS float* s = scr + (8 * c) * 33 + n;
        v4u o; o.x = pk2(s[0 * 33], s[1 * 33]); o.y = pk2(s[2 * 33], s[3 * 33]); o.z = pk2(s[4 * 33], s[5 * 33]); o.w = pk2(s[6 * 33], s[7 * 33]);
        int nr = n0 + n; if (QKPERM && nr < 1280) nr = (nr & ~127) | rope_col(nr & 127);
        *(GAS v4u*)(WT + (size_t)nr * K + k0 + 8 * c) = o; }
    LDS_WAIT(); asm volatile("" ::: "memory");
}

__device__ __forceinline__ void mods_item(const Frame& F, KArgs A, const LAS float* sil, int mi) {
    const int l = mi / 96, cb = mi % 96; const int c4 = (F.lane & 31) * 4, kh = F.lane >> 5;
    const float* W = GIN(8) + (size_t)l * 2048 * 12288 + cb * 128 + c4;
    f32x4 a0 = {0.f, 0.f, 0.f, 0.f}, a1 = a0, a2 = a0;
    const float* Wp = W + (size_t)kh * 12288;
    for (int i0 = 0; i0 < 1024; i0 += 16) {
        f32x4 w[16];
#pragma unroll
        for (int j = 0; j < 16; ++j) w[j] = *(const f32x4*)(Wp + (size_t)(2 * j) * 12288);
        Wp += (size_t)32 * 12288;
#pragma unroll
        for (int j = 0; j < 16; ++j) { const int k = 2 * (i0 + j) + kh; a0 += sil[k] * w[j]; a1 += sil[2048 + k] * w[j]; a2 += sil[4096 + k] * w[j]; }
    }
#pragma unroll
    for (int e = 0; e < 4; ++e) { a0[e] += __shfl_xor(a0[e], 32); a1[e] += __shfl_xor(a1[e], 32); a2[e] += __shfl_xor(a2[e], 32); }
    if (F.lane < 32) {
        const f32x4 bias = *(const f32x4*)(GIN(9) + l * 12288 + cb * 128 + c4);
        float* M = (float*)(F.ws + WS_MODS) + (size_t)(l * 3) * 12288 + cb * 128 + c4;
        *(f32x4*)(M) = a0 + bias; *(f32x4*)(M + 12288) = a1 + bias; *(f32x4*)(M + 2 * 12288) = a2 + bias;
    }
}

__device__ __forceinline__ void p0_prologue(const Frame& F, KArgs A) {
    LAS float* sil = (LAS float*)(F.lds + 73728);
    for (int e = F.tid; e < 3 * 2048; e += 512) { const int j = e >> 11, k = e & 2047; const float c = (j == 0) ? GIN(7)[k] : GIN(6)[(j - 1) * 2048 + k]; sil[e] = c / (1.f + __expf(-c)); }
    __syncthreads();
    for (int mi = F.vcu + F.G * F.wave; mi < 384; mi += F.G * 8) mods_item(F, A, sil, mi);
    if (blockIdx.x == 0) {
        float* rope = (float*)(F.ws + WS_ROPE);
        for (int e = F.tid; e < 80 * 32; e += 512) { const int p = e >> 5, i = e & 31; const int pos = p < 16 ? p : p - 16;
            const float inv = exp2f(-(float)i * (13.287712379549449f / 32.f)); const float ang = (float)pos * inv;
            rope[2 * e] = cosf(ang); rope[2 * e + 1] = sinf(ang); }
        float* LB = (float*)(F.ws + WS_LB);
        for (int e = F.tid; e < 2048; e += 512) { const int dir = e >> 10, j = e & 1023; const float* lg = GIN(13) + (size_t)dir * 4096 + j;
            const float x0 = lg[0], x1 = lg[1024], x2 = lg[2048], x3 = lg[3072]; const float m = fmaxf(fmaxf(x0, x1), fmaxf(x2, x3));
            const float e0 = expf(x0 - m), e1 = expf(x1 - m), e2 = expf(x2 - m), e3 = expf(x3 - m); const float is = 1.f / (e0 + e1 + e2 + e3);
            float* o = LB + (size_t)dir * 4096 + j; o[0] = 0.f; o[1024] = e1 * is; o[2048] = (e1 + e2) * is; o[3072] = (e1 + e2 + e3) * is; }
    }
    {
        const int gt = F.vcu * 512 + F.tid, NGT = F.G * 512;
        for (int i = gt; i < 2 * 131072; i += NGT) { const bool isk = i < 131072; const int j = isk ? i : i - 131072; const float* src = (isk ? GIN(2) : GIN(3)) + (size_t)j * 8;
            const f32x4 x0 = *(const f32x4*)src, x1 = *(const f32x4*)(src + 4);
            if (isk) {
                bf16* dst = (bf16*)(F.ws + WS_CKB) + (((size_t)j * 8) & ~(size_t)127) + rope_col((j * 8) & 127);
                dst[0] = (bf16)f2bf(x0[0]); dst[2] = (bf16)f2bf(x0[1]); dst[4] = (bf16)f2bf(x0[2]); dst[6] = (bf16)f2bf(x0[3]);
                dst[8] = (bf16)f2bf(x1[0]); dst[10] = (bf16)f2bf(x1[1]); dst[12] = (bf16)f2bf(x1[2]); dst[14] = (bf16)f2bf(x1[3]);
            } else { v4u o; o.x = pk2(x0[0], x0[1]); o.y = pk2(x0[2], x0[3]); o.z = pk2(x1[0], x1[1]); o.w = pk2(x1[2], x1[3]); *(v4u*)((bf16*)(F.ws + WS_CVB) + (size_t)j * 8) = o; } }
    }
    LAS float* scr = (LAS float*)(F.lds + F.wave * 8704);
    const int gw = F.vcu * 8 + F.wave, NGW = F.G * 8;
    constexpr int I_IN = 32 * 208, I_O = 32 * 64, I_UP = 32 * 256, I_DN = 128 * 64, I_L = I_IN + I_O + I_UP + I_DN;
    for (int it = gw; it < 4 * I_L; it += NGW) {
        const int l = it / I_L; int r = it % I_L;
        if (r < I_IN) { p0_transpose_item<true>(GIN(10) + (size_t)l * 2048 * 6656, 2048, 6656, (bf16*)(F.ws + WS_WIN) + (size_t)l * 6656 * 2048, scr, r, F.lane); continue; } r -= I_IN;
        if (r < I_O) { p0_transpose_item<false>(GIN(15) + (size_t)l * 2048 * 2048, 2048, 2048, (bf16*)(F.ws + WS_WO) + (size_t)l * 2048 * 2048, scr, r, F.lane); continue; } r -= I_O;
        if (r < I_UP) { p0_transpose_item<false>(GIN(18) + (size_t)l * 2048 * 8192, 2048, 8192, (bf16*)(F.ws + WS_WUP) + (size_t)l * 8192 * 2048, scr, r, F.lane); continue; } r -= I_UP;
        { const int kb = r >> 6, nb = r & 63, ks = kb >> 5;
          p0_transpose_item<false>(GIN(19) + ((size_t)l * 8192 + (size_t)ks * 2048) * 2048, 2048, 2048, (bf16*)(F.ws + WS_WDN) + ((size_t)l * 4 + ks) * 2048 * 2048, scr, (kb & 31) * 64 + nb, F.lane); }
    }
}

__device__ __forceinline__ int cond_of_row(int r) { return r < NPR ? 0 : 1 + ((r - NPR) >> 10); }

__device__ __forceinline__ void modulate0_phase(const Frame& F, KArgs A) {
    const int gw = F.vcu * 8 + F.wave, NGW = F.G * 8; const float* MODS = (const float*)(F.ws + WS_MODS); bf16* H = (bf16*)(F.ws + WS_H);
    for (int r = gw; r < MT; r += NGW) {
        const float* xr = r < NPR ? GIN(0) + (size_t)r * DM : GIN(1) + (size_t)(r - NPR) * DM; const float* md = MODS + (size_t)cond_of_row(r) * 12288;
#pragma unroll
        for (int j = 0; j < 8; ++j) { const int c = (F.lane + 64 * j) * 4; const f32x4 x = *(const f32x4*)(xr + c), sc = *(const f32x4*)(md + 2048 + c), sh = *(const f32x4*)(md + c);
            const f32x4 h = x * (1.f + sc) + sh; v2u o; o.x = pk2(h[0], h[1]); o.y = pk2(h[2], h[3]); *(v2u*)(H + (size_t)r * DM + c) = o; }
    }
}

__device__ __forceinline__ void ln_phase(const Frame& F, KArgs A, int l, int which, int r_begin, int r_end, int gw, int NGW) {
    const float* MODS = (const float*)(F.ws + WS_MODS); bf16* H = (bf16*)(F.ws + WS_H);
    const float* Y = (const float*)(F.ws + WS_Y); const bool last = (which == 1 && l == 3); float* X = last ? F.out : (float*)(F.ws + WS_X);
    const float* lg = GIN(16) + (size_t)(l * 2 + which) * DM; const float* lb = GIN(17) + (size_t)(l * 2 + which) * DM;
    for (int r = r_begin + gw; r < r_end; r += NGW) {
        const float* yr = (which == 1 ? (const float*)(F.ws + WS_X) : Y) + (size_t)r * DM; f32x4 v[8]; float s = 0.f;
#pragma unroll
        for (int j = 0; j < 8; ++j) { v[j] = *(const f32x4*)(yr + (F.lane + 64 * j) * 4);
            if (which == 1) {
                v[j] = v[j] * DN_ALPHA;
                const bf16* sl = (const bf16*)(F.ws + WS_SL) + (size_t)r * DM + (F.lane + 64 * j) * 4;
#pragma unroll
                for (int k = 0; k < 4; ++k) { const v2u w = *(const v2u*)(sl + (size_t)k * MT * DM); v[j][0] += bflo(w.x); v[j][1] += bfhi(w.x); v[j][2] += bflo(w.y); v[j][3] += bfhi(w.y); } }
            s += (v[j][0] + v[j][1]) + (v[j][2] + v[j][3]); }
        const float mean = wave_sum(s) * (1.f / DM); float s2 = 0.f;
#pragma unroll
        for (int j = 0; j < 8; ++j) { v[j] = v[j] - mean; s2 += (v[j][0] * v[j][0] + v[j][1] * v[j][1]) + (v[j][2] * v[j][2] + v[j][3] * v[j][3]); }
        const float rstd = 1.f / sqrtf(wave_sum(s2) * (1.f / DM) + LN_EPS);
        const int cond = cond_of_row(r);
        const float* msc = which == 0 ? MODS + (size_t)(l * 3 + cond) * 12288 + 8192 : MODS + (size_t)((l + 1) * 3 + cond) * 12288 + 2048;
        const float* msh = which == 0 ? MODS + (size_t)(l * 3 + cond) * 12288 + 6144 : MODS + (size_t)((l + 1) * 3 + cond) * 12288;
#pragma unroll
        for (int j = 0; j < 8; ++j) { const int c = (F.lane + 64 * j) * 4; const f32x4 g = *(const f32x4*)(lg + c), b = *(const f32x4*)(lb + c);
            const f32x4 x = v[j] * rstd * g + b; *(f32x4*)(X + (size_t)r * DM + c) = x;
            if (!last) { const f32x4 sc = *(const f32x4*)(msc + c), sh = *(const f32x4*)(msh + c); const f32x4 h = x * (1.f + sc) + sh;
                v2u o; o.x = pk2(h[0], h[1]); o.y = pk2(h[2], h[3]); *(v2u*)(H + (size_t)r * DM + c) = o; } }
    }
}

namespace pg8 {
__device__ __forceinline__ void tile_of(int wgid, int nM, int nN, int& pm, int& pn) {
    const int nig = WGM * nN, gid = wgid / nig, fm = gid * WGM, gsz = (nM - fm) < WGM ? (nM - fm) : WGM;
    pm = fm + ((wgid % nig) % gsz); pn = (wgid % nig) / gsz;
}
struct InOrder {
    int G, c;
    __device__ __forceinline__ bool next(int i, Unit& u) const {
        const int L = i * G + c; if (L >= 1024) return false;
        const int wgid = (L & 7) * 128 + (L >> 3);
        if (wgid < 880) tile_of(wgid, 40, 22, u.pm, u.pn); else { tile_of(wgid - 880, 36, 4, u.pm, u.pn); u.pn += 22; }
        u.ks = 0; return true;
    }
    __device__ __forceinline__ void a_ready(const Unit&) const {}
    __device__ __forceinline__ void done(const Unit&) const {}
};
struct OneUnit {
    int pm, pn;
    __device__ __forceinline__ bool next(int i, Unit& u) const { if (i) return false; u.pm = pm; u.pn = pn; u.ks = 0; return true; }
    __device__ __forceinline__ void a_ready(const Unit&) const {}
    __device__ __forceinline__ void done(const Unit&) const {}
};
struct SplitOrder : StaticOrder {
    __device__ __forceinline__ bool next(int i, Unit& u) const { if (!StaticOrder::next(i, u)) return false; u.ks = u.pn >> 3; u.pn &= 7; return true; }
};
struct EpiIn {
    static constexpr bool PERM = true, AFTER_DRAIN = false;
    bf16_t *Q, *KB, *VB, *HQ, *HI, *HG; float *ZF, *ZB, *outK, *outV; const float* rope;
    __device__ __forceinline__ void operator()(const f32x4 (&acc)[2][2][4][2], const Unit& u, int wr, int wc, int fr, int fq) const {
        const int pn = u.pn, rbase = u.pm * BM + wr * 64 + fr, cl = wc * 32 + 8 * fq;
        if (pn >= 10 && pn < 18) {
            float* dst = (pn < 14 ? ZF + (pn - 10) * 256 : ZB + (pn - 14) * 256) + cl;
#pragma unroll
            for (int ai = 0; ai < 2; ++ai)
#pragma unroll
                for (int m = 0; m < 4; ++m) { float* rowp = dst + (size_t)(rbase + ai * HALF + m * 16) * 1024;
#pragma unroll
                    for (int bj = 0; bj < 2; ++bj) { *(f32x4*)(rowp + bj * HALF) = acc[ai][bj][m][0]; *(f32x4*)(rowp + bj * HALF + 4) = acc[ai][bj][m][1]; } }
        } else {
            bf16_t* dst; int ld = 1024; bool act = false; float* of = nullptr;
            if (pn < 4) dst = Q + pn * 256;
            else if (pn == 4) { dst = KB; ld = 256; of = outK; }
            else if (pn == 5) { dst = VB; ld = 256; of = outV; }
            else if (pn < 10) { dst = HQ + (pn - 6) * 256; act = true; }
            else if (pn < 22) dst = HI + (pn - 18) * 256;
            else { dst = HG + (pn - 22) * 256; act = true; }
            if (u.pm >= 32) of = nullptr;
            const bool qk = pn <= 4, rot = qk && u.pm >= 32; const int half = wc >> 1, i0 = (wc & 1) * 16 + 4 * fq;
#pragma unroll
            for (int ai = 0; ai < 2; ++ai)
#pragma unroll
                for (int m = 0; m < 4; ++m) { const int row = rbase + ai * HALF + m * 16; bf16_t* rowp = dst + (size_t)row * ld + cl;
#pragma unroll
                    for (int bj = 0; bj < 2; ++bj) { f32x4 v0 = acc[ai][bj][m][0], v1 = acc[ai][bj][m][1];
                        if (rot) { const int t = (row - 8192) & 1023; const int p = half ? 16 + (t & 63) : (t >> 6); const float* rp = rope + (size_t)(p * 32 + i0) * 2;
                            const f32x4 r0 = *(const f32x4*)rp, r1 = *(const f32x4*)(rp + 4);
                            v0 = (f32x4){v0[0] * r0[0] - v0[1] * r0[1], v0[0] * r0[1] + v0[1] * r0[0], v0[2] * r0[2] - v0[3] * r0[3], v0[2] * r0[3] + v0[3] * r0[2]};
                            v1 = (f32x4){v1[0] * r1[0] - v1[1] * r1[1], v1[0] * r1[1] + v1[1] * r1[0], v1[2] * r1[2] - v1[3] * r1[3], v1[2] * r1[3] + v1[3] * r1[2]}; }
                        if (of) { float* op = of + (size_t)u.pm * 262144 + (size_t)(row - u.pm * BM) * 256 + bj * HALF;
                            if (pn == 4) { op += half * 64 + i0; *(f32x4*)op = (f32x4){v0[0], v0[2], v1[0], v1[2]}; *(f32x4*)(op + 32) = (f32x4){v0[1], v0[3], v1[1], v1[3]}; }
                            else { op += cl; *(f32x4*)op = v0; *(f32x4*)(op + 4) = v1; } }
                        if (act) {
#pragma unroll
                            for (int e = 0; e < 4; ++e) { v0[e] = siluf(v0[e]); v1[e] = siluf(v1[e]); } }
                        u32x4 w; w.x = cvt_pk_bf16(v0[0], v0[1]); w.y = cvt_pk_bf16(v0[2], v0[3]); w.z = cvt_pk_bf16(v1[0], v1[1]); w.w = cvt_pk_bf16(v1[2], v1[3]);
                        *(u32x4*)(rowp + bj * HALF) = w; } }
        }
    }
};
struct EpiRes {
    static constexpr bool PERM = false, AFTER_DRAIN = false;
    const float* xp; const float* xs; float* Y; const float* gate0;
    __device__ __forceinline__ void operator()(const f32x4 (&acc)[2][2][4][2], const Unit& u, int wr, int wc, int fr, int fq) const {
        const int cond = u.pm < 32 ? 0 : 1 + ((u.pm - 32) >> 2); const float* gate = gate0 + (size_t)cond * 12288;
        const int col0 = u.pn * BM + wc * 32 + 4 * fq; const int r0 = u.pm * BM + wr * 64 + fr;
        const float* __restrict__ xb = (u.pm < 32 ? xp + (size_t)r0 * 2048 : xs + (size_t)(r0 - 8192) * 2048) + col0; float* __restrict__ yb = Y + (size_t)r0 * 2048 + col0;
        f32x4 gv[2][2];
#pragma unroll
        for (int bj = 0; bj < 2; ++bj)
#pragma unroll
            for (int n = 0; n < 2; ++n) gv[bj][n] = *(const f32x4*)(gate + col0 + bj * HALF + n * 16);
        f32x4 xc[2][2], xn[2][2];
#pragma unroll
        for (int bj = 0; bj < 2; ++bj)
#pragma unroll
            for (int n = 0; n < 2; ++n) xc[bj][n] = *(const f32x4*)(xb + bj * HALF + n * 16);
#pragma unroll
        for (int it = 0; it < 8; ++it) { const int ai = it >> 2, m = it & 3; const size_t ro = (size_t)(ai * HALF + m * 16) * 2048;
            if (it < 7) { const int ai2 = (it + 1) >> 2, m2 = (it + 1) & 3; const size_t rn = (size_t)(ai2 * HALF + m2 * 16) * 2048;
#pragma unroll
                for (int bj = 0; bj < 2; ++bj)
#pragma unroll
                    for (int n = 0; n < 2; ++n) xn[bj][n] = *(const f32x4*)(xb + rn + bj * HALF + n * 16); }
#pragma unroll
            for (int bj = 0; bj < 2; ++bj)
#pragma unroll
                for (int n = 0; n < 2; ++n) { *(f32x4*)(yb + ro + bj * HALF + n * 16) = DN_ALPHA * xc[bj][n] + gv[bj][n] * acc[ai][bj][m][n]; xc[bj][n] = xn[bj][n]; } }
    }
};
struct EpiDown {
    static constexpr bool PERM = true, AFTER_DRAIN = false;
    bf16_t* SL; const float* gate0;
    __device__ __forceinline__ void operator()(const f32x4 (&acc)[2][2][4][2], const Unit& u, int wr, int wc, int fr, int fq) const {
        const int cond = u.pm < 32 ? 0 : 1 + ((u.pm - 32) >> 2); const float* gate = gate0 + (size_t)cond * 12288;
        const int col0 = u.pn * BM + wc * 32 + 8 * fq; const int r0 = u.pm * BM + wr * 64 + fr;
        f32x4 gv[2][2];
#pragma unroll
        for (int bj = 0; bj < 2; ++bj)
#pragma unroll
            for (int n = 0; n < 2; ++n) gv[bj][n] = *(const f32x4*)(gate + col0 + bj * HALF + n * 4);
        bf16_t* sl = SL + (size_t)u.ks * MT * 2048;
#pragma unroll
        for (int ai = 0; ai < 2; ++ai)
#pragma unroll
            for (int m = 0; m < 4; ++m) { bf16_t* sr = sl + (size_t)(r0 + ai * HALF + m * 16) * 2048 + col0;
#pragma unroll
                for (int bj = 0; bj < 2; ++bj) { const f32x4 v0 = gv[bj][0] * acc[ai][bj][m][0], v1 = gv[bj][1] * acc[ai][bj][m][1];
                    u32x4 w; w.x = cvt_pk_bf16(v0[0], v0[1]); w.y = cvt_pk_bf16(v0[2], v0[3]); w.z = cvt_pk_bf16(v1[0], v1[1]); w.w = cvt_pk_bf16(v1[2], v1[3]);
                    *(u32x4*)(sr + bj * HALF) = w; } }
    }
};
struct EpiUp {
    static constexpr bool PERM = true, AFTER_DRAIN = false;
    bf16_t* O;
    __device__ __forceinline__ void operator()(const f32x4 (&acc)[2][2][4][2], const Unit& u, int wr, int wc, int fr, int fq) const {
        const int row0 = u.pm * BM + wr * 64 + fr, col0 = (u.pn & 7) * BM + wc * 32 + 8 * fq;
        bf16_t* Ob = O + (size_t)(u.pn >> 3) * MT * 2048;
#pragma unroll
        for (int ai = 0; ai < 2; ++ai)
#pragma unroll
            for (int m = 0; m < 4; ++m) { bf16_t* rowp = Ob + (size_t)(row0 + ai * HALF + m * 16) * 2048 + col0;
#pragma unroll
                for (int bj = 0; bj < 2; ++bj) { f32x4 v0 = acc[ai][bj][m][0], v1 = acc[ai][bj][m][1];
#pragma unroll
                    for (int e = 0; e < 4; ++e) { const float a = fmaxf(v0[e], 0.f), b = fmaxf(v1[e], 0.f); v0[e] = a * a; v1[e] = b * b; }
                    u32x4 w; w.x = cvt_pk_bf16(v0[0], v0[1]); w.y = cvt_pk_bf16(v0[2], v0[3]); w.z = cvt_pk_bf16(v1[0], v1[1]); w.w = cvt_pk_bf16(v1[2], v1[3]);
                    *(u32x4*)(rowp + bj * HALF) = w; } }
    }
};
}

__device__ __forceinline__ void rope_phase(const Frame& F) {
    const int gw = F.vcu * 8 + F.wave, NGW = F.G * 8; bf16* QB = (bf16*)(F.ws + WS_QB); bf16* KB = (bf16*)(F.ws + WS_KB); const float* rope = (const float*)(F.ws + WS_ROPE);
    for (int i = gw; i < NSR; i += NGW) {
        const int r = NPR + i, t = i & 1023; const int p = F.lane < 32 ? (t >> 6) : 16 + (t & 63); const int dd = F.lane & 31, base = F.lane < 32 ? 0 : 64;
        const float cs = rope[(p * 32 + dd) * 2], sn = rope[(p * 32 + dd) * 2 + 1];
#pragma unroll
        for (int hh = 0; hh < 10; ++hh) { bf16* ptr = hh < 8 ? QB + (size_t)r * 1024 + hh * 128 + base + dd : KB + (size_t)r * 256 + (hh - 8) * 128 + base + dd;
            const float x1 = bf2f(ptr[0]), x2 = bf2f(ptr[32]); ptr[0] = (bf16)f2bf(x1 * cs - x2 * sn); ptr[32] = (bf16)f2bf(x1 * sn + x2 * cs); }
    }
}

__device__ __forceinline__ void attn_task(const Frame& F, KArgs A, int l, int task, char* lds_gen) {
    const att::bf16* QB = (const att::bf16*)(F.ws + WS_QB); const att::bf16* KB = (const att::bf16*)(F.ws + WS_KB); const att::bf16* VB = (const att::bf16*)(F.ws + WS_VB);
    att::bf16* ATT = (att::bf16*)(F.ws + WS_ATT);
    const bool lat = task < 64;
    int h, row0, q0, kstart, nloc, sb = 0;
    if (lat) { sb = task >> 5; h = (task >> 2) & 7; const int qb = task & 3; row0 = NPR + sb * 1024; q0 = qb * 256;
        kstart = q0 - 128 < 0 ? 0 : q0 - 128; const int kend = q0 + 384 > 1024 ? 1024 : q0 + 384; nloc = (kend - kstart) >> 6; }
    else { const int t2 = task - 64; h = t2 & 7; row0 = (t2 >> 3) * 256; q0 = 0; kstart = 0; nloc = 4; }
    const int g = h >> 2;
    const size_t coff = (size_t)((sb * 4 + l) * 512) * 256 + g * 128;
    const att::bf16* Kl = KB + (size_t)(row0 + kstart) * 256 + g * 128; const att::bf16* Vl = VB + (size_t)(row0 + kstart) * 256 + g * 128;
    const att::bf16* Kc = lat ? (const att::bf16*)(F.ws + WS_CKB) + coff : Kl; const att::bf16* Vc = lat ? (const att::bf16*)(F.ws + WS_CVB) + coff : Vl;
    const float sink = GIN(11)[l * 8 + h];
    att::attn_body(QB + (size_t)(row0 + q0) * 1024 + h * 128, Kl, Vl, Kc, Vc, lat ? nloc + 8 : 4, nloc, lat, kstart, q0, sink * 1.4426950408889634f,
                   ATT + (size_t)(row0 + q0) * 1024 + h * 128, lds_gen, F.tid);
}

__device__ __forceinline__ void hgrn_task_lat(const Frame& F, KArgs A, int l, int v) {
    const int bidx = v >> 4, h = (v >> 1) & 7, dir = v & 1; const int row0 = NPR + bidx * 1024;
    const float* LB = (const float*)(F.ws + WS_LB); const size_t soff = ((size_t)((bidx * 4 + l) * 8 + h)) * 16384;
    hg::hgrn_body(F.lds, F.tid, F.wave, (const float*)(F.ws + (dir ? WS_ZB : WS_ZF)), (const hg::bf16*)(F.ws + WS_HQ), (const hg::bf16*)(F.ws + WS_HI),
                  (hg::bf16*)(F.ws + (dir ? WS_OB : WS_OF)), LB + (size_t)(dir * 4 + l) * 1024 + h * 128, (dir ? GIN(5) : GIN(4)) + soff, nullptr, row0, 1024, h * 128, dir);
}
__device__ __forceinline__ void hgrn_task_ctx(const Frame& F, KArgs A, int l, int v) {
    const int bidx = v >> 3, h = v & 7; const float* LB = (const float*)(F.ws + WS_LB); const size_t soff = ((size_t)((bidx * 4 + l) * 8 + h)) * 16384;
    hg::hgrn_dual(F.lds, F.tid, F.wave, (const float*)(F.ws + WS_ZF), (const float*)(F.ws + WS_ZB), (const hg::bf16*)(F.ws + WS_HQ), (const hg::bf16*)(F.ws + WS_HI),
                  (const hg::bf16*)(F.ws + WS_HG), (hg::bf16*)(F.ws + WS_MIX), LB + (size_t)l * 1024 + h * 128, LB + (size_t)(4 + l) * 1024 + h * 128, GIN(14) + (size_t)l * 128,
                  F.out + OUT_SF + soff, F.out + OUT_SB + soff, bidx * 256, h * 128);
}

__device__ __forceinline__ void mix_phase(const Frame& F, KArgs A, int l) {
    const int gw = F.vcu * 8 + F.wave, NGW = F.G * 8; bf16* MIX = (bf16*)(F.ws + WS_MIX);
    const bf16* ATT = (const bf16*)(F.ws + WS_ATT); const bf16* OFp = (const bf16*)(F.ws + WS_OF); const bf16* OBp = (const bf16*)(F.ws + WS_OB); const bf16* HG = (const bf16*)(F.ws + WS_HG);
    const float* ag = GIN(12) + (size_t)l * 1024 + F.lane * 16; const float* hgn = GIN(14) + (size_t)l * 128 + (F.lane & 7) * 16;
#define UNPK8(W_, o) do { const v4u w_ = (W_); o[0] = (f32x4){bflo(w_.x), bfhi(w_.x), bflo(w_.y), bfhi(w_.y)}; o[1] = (f32x4){bflo(w_.z), bfhi(w_.z), bflo(w_.w), bfhi(w_.w)}; } while (0)
    for (int r = gw; r < MT; r += NGW) {
        const size_t ro = (size_t)r * 1024 + F.lane * 16;
        f32x4 a[4]; float ss = 0.f;
        { const v4u wA = *(const v4u*)(ATT + ro), wB = *(const v4u*)(ATT + ro + 8); UNPK8(wA, (a + 0)); UNPK8(wB, (a + 2)); }
#pragma unroll
        for (int j = 0; j < 4; ++j) ss += (a[j][0] * a[j][0] + a[j][1] * a[j][1]) + (a[j][2] * a[j][2] + a[j][3] * a[j][3]);
        const float rs = 1.f / sqrtf(wave_sum(ss) * (1.f / 1024.f) + RMS_EPS);
        v4u w0, w1;
        { const f32x4 g0 = *(const f32x4*)(ag), g1 = *(const f32x4*)(ag + 4), g2 = *(const f32x4*)(ag + 8), g3 = *(const f32x4*)(ag + 12);
          const f32x4 y0 = a[0] * rs * g0, y1 = a[1] * rs * g1, y2 = a[2] * rs * g2, y3 = a[3] * rs * g3;
          w0.x = pk2(y0[0], y0[1]); w0.y = pk2(y0[2], y0[3]); w0.z = pk2(y1[0], y1[1]); w0.w = pk2(y1[2], y1[3]);
          w1.x = pk2(y2[0], y2[1]); w1.y = pk2(y2[2], y2[3]); w1.z = pk2(y3[0], y3[1]); w1.w = pk2(y3[2], y3[3]); }
        *(v4u*)(MIX + (size_t)r * 2048 + F.lane * 16) = w0; *(v4u*)(MIX + (size_t)r * 2048 + F.lane * 16 + 8) = w1;
        if (r < NPR) continue;
        float s2 = 0.f;
        { const v4u fA = *(const v4u*)(OFp + ro), fB = *(const v4u*)(OFp + ro + 8), bA = *(const v4u*)(OBp + ro), bB = *(const v4u*)(OBp + ro + 8);
          f32x4 t[4]; UNPK8(fA, (a + 0)); UNPK8(fB, (a + 2)); UNPK8(bA, (t + 0)); UNPK8(bB, (t + 2));
#pragma unroll
          for (int j = 0; j < 4; ++j) { a[j] += t[j]; s2 += (a[j][0] * a[j][0] + a[j][1] * a[j][1]) + (a[j][2] * a[j][2] + a[j][3] * a[j][3]); } }
        s2 += __shfl_xor(s2, 1); s2 += __shfl_xor(s2, 2); s2 += __shfl_xor(s2, 4);
        const float r2 = 1.f / sqrtf(s2 * (1.f / 128.f) + RMS_EPS);
        const v4u gA = *(const v4u*)(HG + ro), gB = *(const v4u*)(HG + ro + 8);
        { const f32x4 g0 = *(const f32x4*)(hgn), g1 = *(const f32x4*)(hgn + 4), g2 = *(const f32x4*)(hgn + 8), g3 = *(const f32x4*)(hgn + 12);
          f32x4 t[4]; UNPK8(gA, (t + 0)); UNPK8(gB, (t + 2));
          const f32x4 y0 = a[0] * r2 * g0 * t[0], y1 = a[1] * r2 * g1 * t[1], y2 = a[2] * r2 * g2 * t[2], y3 = a[3] * r2 * g3 * t[3];
          w0.x = pk2(y0[0], y0[1]); w0.y = pk2(y0[2], y0[3]); w0.z = pk2(y1[0], y1[1]); w0.w = pk2(y1[2], y1[3]);
          w1.x = pk2(y2[0], y2[1]); w1.y = pk2(y2[2], y2[3]); w1.z = pk2(y3[0], y3[1]); w1.w = pk2(y3[2], y3[3]); }
        *(v4u*)(MIX + (size_t)r * 2048 + 1024 + F.lane * 16) = w0; *(v4u*)(MIX + (size_t)r * 2048 + 1024 + F.lane * 16 + 8) = w1;
    }
#undef UNPK8
}

__global__ void __launch_bounds__(512, 2) fwd_kernel(Args A_byval) {
    KArgs A = (KArgs)__builtin_amdgcn_kernarg_segment_ptr();
    extern __shared__ __attribute__((aligned(16))) unsigned char lds_raw[];
    Frame F;
    F.lds = (LAS unsigned char*)lds_raw; F.ws = (unsigned char*)(GAS unsigned char*)A->ws; F.out = (float*)(GAS float*)A->out; F.ctl = (unsigned*)(F.ws + WS_CTL);
    F.tid = threadIdx.x; F.lane = F.tid & 63; F.wave = __builtin_amdgcn_readfirstlane(F.tid >> 6);
    F.G = gridDim.x; { const int bx = blockIdx.x; F.vcu = (F.G % 8 == 0) ? (bx % 8) * (F.G / 8) + bx / 8 : bx; }
    volatile LAS unsigned* MISC = (volatile LAS unsigned*)(F.lds + MISC_OFF);
    for (int u = F.tid; u < (LDS_BYTES - LDSCTL_OFF) / 4; u += 512) ((LAS unsigned*)(F.lds + LDSCTL_OFF))[u] = 0u;
    __syncthreads();
    (void)xcd_barrier_post(F.ctl + CW_BAR, MISC + 8);
#define PHASE_BEGIN() do { int t_o = threadIdx.x; asm volatile("" : "+v"(t_o)); F.tid = t_o; F.lane = t_o & 63; F.wave = __builtin_amdgcn_readfirstlane(t_o >> 6); } while (0)
#define GRID_BAR() do { unsigned char* w_ = F.ws; asm volatile("" : "+s"(w_)); XcdBarrier b_; b_.bar = (unsigned*)(w_ + WS_CTL) + CW_BAR; b_.x = xb_xcc_id(); b_.st = MISC + 8; xcd_barrier(b_); } while (0)
    unsigned char* ws = F.ws;
    using pg8::bf16_t;

#if EN_P0
    p0_prologue(F, A);
#endif
    GRID_BAR(); PHASE_BEGIN();
#if EN_MOD0
    modulate0_phase(F, A);
#endif
    GRID_BAR(); PHASE_BEGIN();

    for (int l = 0; l < 4; ++l) {
        { int t_o = threadIdx.x; asm volatile("" : "+v"(t_o)); F.tid = t_o; F.lane = t_o & 63; F.wave = __builtin_amdgcn_readfirstlane(t_o >> 6); asm volatile("" : "+s"(A)); ws = (unsigned char*)(GAS unsigned char*)A->ws; F.ws = ws; F.out = (float*)(GAS float*)A->out; F.ctl = (unsigned*)(ws + WS_CTL); }
        const float* MODS_L = (const float*)(ws + WS_MODS) + (size_t)l * 3 * 12288;
#if EN_G1
        { pg8::Gemm g{(const bf16_t*)(ws + WS_H), (const bf16_t*)(ws + WS_WIN) + (size_t)l * IN_DIM * DM, MT, IN_DIM, DM, DM, 0, 0}; pg8::InOrder S{F.G, (int)blockIdx.x};
          pg8::EpiIn E{(bf16_t*)(ws + WS_QB), (bf16_t*)(ws + WS_KB), (bf16_t*)(ws + WS_VB), (bf16_t*)(ws + WS_HQ), (bf16_t*)(ws + WS_HI), (bf16_t*)(ws + WS_HG),
                       (float*)(ws + WS_ZF), (float*)(ws + WS_ZB), F.out + OUT_CK + (size_t)l * 65536, F.out + OUT_CV + (size_t)l * 65536, (const float*)(ws + WS_ROPE)};
          pg8::gemm_phase<pg8::EpiIn, pg8::InOrder, true, true>(F.lds, g, S, E); }
#endif
        GRID_BAR(); PHASE_BEGIN();
        for (;;) {
            if (F.tid == 0) MISC[0] = atomicAdd(F.ctl + CW_Q + 64 * l, 1u);
            __syncthreads();
            const int u = (int)MISC[0];
            __syncthreads();
            if (u >= 624) break;
            PHASE_BEGIN();
            if (u < 16) {
                pg8::Gemm g{(const bf16_t*)(ws + WS_H), (const bf16_t*)(ws + WS_WIN) + (size_t)l * IN_DIM * DM, MT, IN_DIM, DM, DM, 0, 0}; pg8::OneUnit S1{36 + (u >> 2), 22 + (u & 3)};
                pg8::EpiIn E{(bf16_t*)(ws + WS_QB), (bf16_t*)(ws + WS_KB), (bf16_t*)(ws + WS_VB), (bf16_t*)(ws + WS_HQ), (bf16_t*)(ws + WS_HI), (bf16_t*)(ws + WS_HG),
                             (float*)(ws + WS_ZF), (float*)(ws + WS_ZB), F.out + OUT_CK + (size_t)l * 65536, F.out + OUT_CV + (size_t)l * 65536, (const float*)(ws + WS_ROPE)};
                pg8::gemm_phase<pg8::EpiIn, pg8::OneUnit, true, true>(F.lds, g, S1, E);
            }
            else if (u < 48) hgrn_task_lat(F, A, l, u - 16);
            else if (u < 112) attn_task(F, A, l, u - 48, (char*)lds_raw);
            else if (u < 368) hgrn_task_ctx(F, A, l, u - 112);
            else attn_task(F, A, l, u - 304, (char*)lds_raw);
        }
        GRID_BAR(); PHASE_BEGIN();
#if EN_MIX
        mix_phase(F, A, l);
#endif
        GRID_BAR(); PHASE_BEGIN();
        { pg8::Gemm g{(const bf16_t*)(ws + WS_MIX), (const bf16_t*)(ws + WS_WO) + (size_t)l * DM * DM, MT, DM, DM, DM, 0, 0};
          const float* xp = l == 0 ? GIN(0) : (const float*)(ws + WS_X); const float* xs = l == 0 ? GIN(1) : (const float*)(ws + WS_X) + (size_t)NPR * DM;
          pg8::EpiRes E{xp, xs, (float*)(ws + WS_Y), MODS_L + 4096};
          { pg8::StaticOrder S; S.init(NPR, DM, F.G, (int)blockIdx.x); pg8::gemm_phase<pg8::EpiRes, pg8::StaticOrder, true, true>(F.lds, g, S, E); }
          GRID_BAR(); PHASE_BEGIN();
          if (F.G >= 128) {
              if (blockIdx.x < 64) { pg8::OneUnit S1{32 + ((int)blockIdx.x >> 3), (int)blockIdx.x & 7}; pg8::gemm_phase<pg8::EpiRes, pg8::OneUnit, true, true>(F.lds, g, S1, E); }
              else ln_phase(F, A, l, 0, 0, NPR, ((int)blockIdx.x - 64) * 8 + F.wave, (F.G - 64) * 8);
          } else {
              for (int uu = (int)blockIdx.x; uu < 64; uu += F.G) { pg8::OneUnit S1{32 + (uu >> 3), uu & 7}; pg8::gemm_phase<pg8::EpiRes, pg8::OneUnit, true, true>(F.lds, g, S1, E); }
              ln_phase(F, A, l, 0, 0, NPR, F.vcu * 8 + F.wave, F.G * 8);
          }
        }
        GRID_BAR(); PHASE_BEGIN();
        ln_phase(F, A, l, 0, NPR, MT, F.vcu * 8 + F.wave, F.G * 8);
        GRID_BAR(); PHASE_BEGIN();
#if EN_G5
        { pg8::Gemm g{(const bf16_t*)(ws + WS_H), (const bf16_t*)(ws + WS_WUP) + (size_t)l * DFF * DM, MT, DFF, DM, DM, 0, 0}; pg8::StaticOrder S; S.init(MT, DFF, F.G, (int)blockIdx.x);
          pg8::EpiUp E{(bf16_t*)(ws + WS_ACT)};
          pg8::gemm_phase<pg8::EpiUp, pg8::StaticOrder, true, true>(F.lds, g, S, E); }
#endif
        GRID_BAR(); PHASE_BEGIN();
#if EN_G6
        { pg8::Gemm g{(const bf16_t*)(ws + WS_ACT), (const bf16_t*)(ws + WS_WDN) + (size_t)l * DM * DFF, MT, DM, 2048, 2048, (size_t)MT * 2048 * 2, (size_t)2048 * 2048 * 2}; pg8::SplitOrder S; S.init(MT, 8192, F.G, (int)blockIdx.x);
          pg8::EpiDown E{(bf16_t*)(ws + WS_SL), MODS_L + 10240};
          pg8::gemm_phase<pg8::EpiDown, pg8::SplitOrder, true, true>(F.lds, g, S, E); }
#endif
        GRID_BAR(); PHASE_BEGIN();
#if EN_LN
        ln_phase(F, A, l, 1, 0, MT, F.vcu * 8 + F.wave, F.G * 8);
#endif
        GRID_BAR(); PHASE_BEGIN();
    }
}

extern "C" void kernel_launch(void* const* d_in, const int* in_sizes, int n_in, void* d_out, int out_size, void* d_ws, size_t ws_size, hipStream_t stream) {
    static int grid = 0;
    if (grid == 0) {
        if (n_in != 20 || ws_size < WS_END) { fprintf(stderr, "kernel_launch: unexpected n_in %d / ws %zu\n", n_in, ws_size); grid = -1; return; }
        int dev = 0, cus = 0, per_cu = 0;
        if (hipGetDevice(&dev) != hipSuccess || hipDeviceGetAttribute(&cus, hipDeviceAttributeMultiprocessorCount, dev) != hipSuccess) { grid = -1; return; }
        if (hipFuncSetAttribute((const void*)fwd_kernel, hipFuncAttributeMaxDynamicSharedMemorySize, LDS_BYTES) != hipSuccess) { fprintf(stderr, "kernel_launch: hipFuncSetAttribute failed\n"); grid = -1; return; }
        if (hipOccupancyMaxActiveBlocksPerMultiprocessor(&per_cu, (const void*)fwd_kernel, 512, LDS_BYTES) != hipSuccess || per_cu < 1) fprintf(stderr, "kernel_launch: occupancy query says %d\n", per_cu);
        (void)hipGetLastError();
        grid = cus;
    }
    if (grid < 0) return;
    if (hipMemsetAsync((char*)d_ws + WS_CTL, 0, CTL_ZERO_BYTES, stream) != hipSuccess) return;
    Args a{};
    for (int i = 0; i < 20; ++i) a.in[i] = (const float*)d_in[i];
    a.out = (float*)d_out; a.ws = (unsigned char*)d_ws;
    hipLaunchKernelGGL(fwd_kernel, dim3(grid), dim3(512), LDS_BYTES, stream, a);
}
```

```cpp
#include <hip/hip_runtime.h>
#include <cstdio>
#include <cstdint>
namespace pg8 {
#define PG8_LAS __attribute__((address_space(3)))
typedef unsigned short bf16_t;
typedef short bf16x8 __attribute__((ext_vector_type(8)));
typedef float f32x4 __attribute__((ext_vector_type(4)));
typedef unsigned u32x4 __attribute__((ext_vector_type(4)));
constexpr int BM = 256, BK = 64, HALF = 128, HTB = HALF * BK * 2  , STAGE_BYTES = 8 * HTB, NXCD = 8, WGM = 8;

__host__ __device__ __forceinline__ int lds_byte(int r, int c) { const int st = (r >> 4) * 2 + (c >> 5), rr = r & 15, cc = c & 31, ob = rr * 64 + cc * 2; return st * 1024 + (ob ^ (((ob >> 9) & 1) << 5)); }
__host__ __device__ __forceinline__ void stage_rc(int b, int& R, int& C) { const int st = b / 1024, sb = b % 1024, swz = sb ^ (((sb >> 9) & 1) << 5); R = (st >> 1) * 16 + swz / 64; C = (st & 1) * 32 + (swz % 64) / 2; }
__host__ __device__ __forceinline__ int perm32(int rho) { const int n = rho >> 4, i = rho & 15; return 8 * (i >> 2) + 4 * n + (i & 3); }

struct Unit { int pm, pn, ks; };
struct Gemm { const bf16_t* A; const bf16_t* Bt; int M, N, K, ld; size_t ksA, ksB; };

struct StaticOrder {
    int nM, nN, nwg, G, c;
    __host__ __device__ void init(int M, int N, int G_, int c_) { nM = M / BM; nN = N / BM; nwg = nM * nN; G = G_; c = c_; }
    __host__ __device__ bool next(int i, Unit& u) const {
        const long L = (long)i * G + c; if (L >= nwg) return false;
        int wgid = (int)L; { const int q = nwg / NXCD, r = nwg % NXCD, xcd = wgid % NXCD, off = wgid / NXCD; wgid = (xcd < r ? xcd * (q + 1) : r * (q + 1) + (xcd - r) * q) + off; }
        const int nig = WGM * nN, gid = wgid / nig, fm = gid * WGM, gsz = (nM - fm) < WGM ? (nM - fm) : WGM;
        u.pm = fm + ((wgid % nig) % gsz); u.pn = (wgid % nig) / gsz; u.ks = 0; return true;
    }
    __device__ __forceinline__ void a_ready(const Unit&) const {}
    __device__ __forceinline__ void done(const Unit&) const {}
};

__device__ __forceinline__ unsigned cvt_pk_bf16(float lo, float hi) { unsigned r; asm volatile("v_cvt_pk_bf16_f32 %0, %1, %2" : "=v"(r) : "v"(lo), "v"(hi)); return r; }
template <class Epi, class Sched, bool ALIGN_EPI = false, bool SP2 = false>
__device__ __forceinline__ void gemm_phase(PG8_LAS unsigned char* lds, const Gemm g, const Sched& S, const Epi& E) {
    int tid_o = threadIdx.x; asm volatile("" : "+v"(tid_o));
    const int tid = tid_o, wid = __builtin_amdgcn_readfirstlane(tid >> 6), lane = tid & 63, wr = wid >> 2, wc = wid & 3, fr = lane & 15, fq = lane >> 4;
    const int K = g.K, nt = K / BK, LD = g.ld;
    unsigned voffA[2], voffB[2];
#pragma unroll
    for (int i = 0; i < 2; ++i) { int R, C; stage_rc(tid * 16 + i * 8192, R, C); const int Rb = Epi::PERM ? ((R & ~31) + perm32(R & 31)) : R;
        voffA[i] = (unsigned)(R * LD + C) * 2u; voffB[i] = (unsigned)(Rb * LD + C) * 2u; }
    const size_t kstep = (size_t)(BK * 2);
    const size_t hstep = (size_t)HALF * LD * 2;
    const size_t tstep = 2 * hstep;
    const unsigned ldsw = (unsigned)wid * 1024u;
    const int aoff = lds_byte(wr * 64 + fr, fq * 8), boff = lds_byte(wc * 32 + fr, fq * 8);
#define PG8_SA(b, h) (((b) * 2 + (h)) * HTB)
#define PG8_SB(b, h) ((4 + (b) * 2 + (h)) * HTB)
#define PG8_STAGE(bufoff, gbase, voff) do { _Pragma("unroll") for (int _i = 0; _i < 2; ++_i) \
        __builtin_amdgcn_global_load_lds((const unsigned*)((const char*)(gbase) + (voff)[_i]), (PG8_LAS unsigned*)(lds + (bufoff) + ldsw + _i * 8192), 16, 0, 0); } while (0)
#define PG8_LDA(dst, b, h) do { _Pragma("unroll") for (int m = 0; m < 4; ++m) _Pragma("unroll") for (int k = 0; k < 2; ++k) dst[m][k] = *(const PG8_LAS bf16x8*)(lds + PG8_SA(b, h) + aoff + m * 2048 + k * 1024); } while (0)
#define PG8_LDB(dst, b, h) do { _Pragma("unroll") for (int n = 0; n < 2; ++n) _Pragma("unroll") for (int k = 0; k < 2; ++k) dst[n][k] = *(const PG8_LAS bf16x8*)(lds + PG8_SB(b, h) + boff + n * 2048 + k * 1024); } while (0)
#define PG8_MMA(ai, bj, At, Bt) do { __builtin_amdgcn_s_setprio(1); _Pragma("unroll") for (int m = 0; m < 4; ++m) _Pragma("unroll") for (int n = 0; n < 2; ++n) _Pragma("unroll") for (int k = 0; k < 2; ++k) \
        acc[ai][bj][m][n] = __builtin_amdgcn_mfma_f32_16x16x32_bf16(Bt[n][k], At[m][k], acc[ai][bj][m][n], 0, 0, 0); __builtin_amdgcn_s_setprio(0); } while (0)
#define PG8_WAIT_V(n) asm volatile("s_waitcnt vmcnt(" #n ")" ::: "memory")
#define PG8_WAIT_L(n) asm volatile("s_waitcnt lgkmcnt(" #n ")" ::: "memory")
#define PG8_BAR __builtin_amdgcn_s_barrier()
#define PG8_SCHED __builtin_amdgcn_sched_barrier(0)
    Unit cur, nxt; int ui = 0;
    if (!S.next(0, cur)) return;
    f32x4 acc[2][2][4][2];
#pragma unroll
    for (int a = 0; a < 2; ++a)
#pragma unroll
        for (int b = 0; b < 2; ++b)
#pragma unroll
            for (int m = 0; m < 4; ++m)
#pragma unroll
                for (int n = 0; n < 2; ++n) acc[a][b][m][n] = (f32x4){0.f, 0.f, 0.f, 0.f};
    bf16x8 At[4][2], B0[2][2], B1[2][2];
        const char* cA = (const char*)g.A + (size_t)cur.pm * tstep + (size_t)cur.ks * g.ksA; const char* cB = (const char*)g.Bt + (size_t)cur.pn * tstep + (size_t)cur.ks * g.ksB;
    S.a_ready(cur);
    if constexpr (SP2) {
        PG8_STAGE(PG8_SB(0, 0), cB, voffB); PG8_STAGE(PG8_SB(0, 1), cB + hstep, voffB); PG8_STAGE(PG8_SA(0, 0), cA, voffA); PG8_STAGE(PG8_SA(0, 1), cA + hstep, voffA);
        if (wr == 1) PG8_BAR;
        PG8_WAIT_V(2); PG8_BAR;
        PG8_STAGE(PG8_SB(1, 0), cB + kstep, voffB); PG8_STAGE(PG8_SA(1, 0), cA + kstep, voffA); PG8_STAGE(PG8_SB(1, 1), cB + hstep + kstep, voffB);
        PG8_WAIT_V(6); PG8_BAR;
    } else {
        PG8_STAGE(PG8_SB(0, 0), cB, voffB); PG8_STAGE(PG8_SA(0, 0), cA, voffA); PG8_STAGE(PG8_SB(0, 1), cB + hstep, voffB); PG8_STAGE(PG8_SA(0, 1), cA + hstep, voffA);
        if (wr == 1) PG8_BAR;
        PG8_WAIT_V(4); PG8_BAR;
        PG8_STAGE(PG8_SB(1, 0), cB + kstep, voffB); PG8_STAGE(PG8_SA(1, 0), cA + kstep, voffA); PG8_STAGE(PG8_SB(1, 1), cB + hstep + kstep, voffB);
        PG8_WAIT_V(6); PG8_BAR;
    }
    for (;;) {
        const bool has_next = S.next(ui + 1, nxt);
        const char* nA = has_next ? (const char*)g.A + (size_t)nxt.pm * tstep + (size_t)nxt.ks * g.ksA : cA; const char* nB = has_next ? (const char*)g.Bt + (size_t)nxt.pn * tstep + (size_t)nxt.ks * g.ksB : cB;
        for (int t = 0; t < nt; t += 2) {
            const bool last = (t == nt - 2);
            const char* a1 = cA + (size_t)(t + 1) * kstep;
            const char* a2 = last ? nA : cA + (size_t)(t + 2) * kstep; const char* b2 = last ? nB : cB + (size_t)(t + 2) * kstep;
            const char* a3 = a2 + kstep; const char* b3 = b2 + kstep;
            if (last && has_next) S.a_ready(nxt);
            if constexpr (SP2) {
            PG8_LDB(B0, 0, 0); PG8_LDB(B1, 0, 1); PG8_SCHED; PG8_LDA(At, 0, 0); PG8_STAGE(PG8_SA(1, 1), a1 + hstep, voffA);
            PG8_WAIT_V(8); PG8_WAIT_L(0); PG8_BAR; PG8_MMA(0, 0, At, B0); PG8_MMA(0, 1, At, B1); PG8_BAR; PG8_SCHED;
            PG8_LDA(At, 0, 1); PG8_STAGE(PG8_SB(0, 0), b2, voffB); PG8_STAGE(PG8_SB(0, 1), b2 + hstep, voffB); PG8_STAGE(PG8_SA(0, 0), a2, voffA);
            PG8_WAIT_V(8); PG8_WAIT_L(0); PG8_BAR; PG8_MMA(1, 0, At, B0); PG8_MMA(1, 1, At, B1); PG8_BAR; PG8_SCHED;
            PG8_LDB(B0, 1, 0); PG8_LDB(B1, 1, 1); PG8_SCHED; PG8_LDA(At, 1, 0); PG8_STAGE(PG8_SA(0, 1), a2 + hstep, voffA);
            PG8_WAIT_V(8); PG8_WAIT_L(0); PG8_BAR; PG8_MMA(0, 0, At, B0); PG8_MMA(0, 1, At, B1); PG8_BAR; PG8_SCHED;
            PG8_LDA(At, 1, 1); PG8_STAGE(PG8_SB(1, 0), b3, voffB); PG8_STAGE(PG8_SB(1, 1), b3 + hstep, voffB); PG8_STAGE(PG8_SA(1, 0), a3, voffA);
            PG8_WAIT_V(8); PG8_WAIT_L(0); PG8_BAR; PG8_MMA(1, 0, At, B0); PG8_MMA(1, 1, At, B1); PG8_BAR; PG8_SCHED;
            } else {
            PG8_LDB(B0, 0, 0); PG8_SCHED; PG8_LDA(At, 0, 0); PG8_STAGE(PG8_SA(1, 1), a1 + hstep, voffA);
            PG8_WAIT_L(8); PG8_BAR; PG8_WAIT_L(0); PG8_MMA(0, 0, At, B0); PG8_BAR; PG8_SCHED;
            PG8_LDB(B1, 0, 1); PG8_STAGE(PG8_SB(0, 0), b2, voffB);
            PG8_BAR; PG8_WAIT_L(0); PG8_MMA(0, 1, At, B1); PG8_BAR;
            PG8_LDA(At, 0, 1); PG8_STAGE(PG8_SA(0, 0), a2, voffA);
            PG8_BAR; PG8_WAIT_L(0); PG8_MMA(1, 0, At, B0); PG8_BAR; PG8_SCHED;
            PG8_STAGE(PG8_SB(0, 1), b2 + hstep, voffB);
            PG8_WAIT_V(6); PG8_BAR; PG8_MMA(1, 1, At, B1); PG8_BAR;
            PG8_LDB(B0, 1, 0); PG8_SCHED; PG8_LDA(At, 1, 0); PG8_STAGE(PG8_SA(0, 1), a2 + hstep, voffA);
            PG8_WAIT_L(8); PG8_BAR; PG8_WAIT_L(0); PG8_MMA(0, 0, At, B0); PG8_BAR; PG8_SCHED;
            PG8_LDB(B1, 1, 1); PG8_STAGE(PG8_SB(1, 0), b3, voffB);
            PG8_BAR; PG8_WAIT_L(0); PG8_MMA(0, 1, At, B1); PG8_BAR;
            PG8_LDA(At, 1, 1); PG8_STAGE(PG8_SA(1, 0), a3, voffA);
            PG8_BAR; PG8_WAIT_L(0); PG8_MMA(1, 0, At, B0); PG8_BAR; PG8_SCHED;
            PG8_STAGE(PG8_SB(1, 1), b3 + hstep, voffB);
            PG8_WAIT_V(6); PG8_BAR; PG8_MMA(1, 1, At, B1); PG8_BAR;
            }
        }
        if constexpr (ALIGN_EPI) { if (wr == 0) PG8_BAR; }
        if constexpr (!Epi::AFTER_DRAIN) { E(acc, cur, wr, wc, fr, fq); S.done(cur); }
        if (!has_next) break;
#pragma unroll
        for (int a = 0; a < 2; ++a)
#pragma unroll
            for (int b = 0; b < 2; ++b)
#pragma unroll
                for (int m = 0; m < 4; ++m)
#pragma unroll
                    for (int n = 0; n < 2; ++n) acc[a][b][m][n] = (f32x4){0.f, 0.f, 0.f, 0.f};
        cur = nxt; cA = nA; cB = nB; ++ui;
        if constexpr (ALIGN_EPI) { if (wr == 1) PG8_BAR; }
    }
    PG8_WAIT_V(0);
    if constexpr (!ALIGN_EPI) { if (wr == 0) PG8_BAR; }
    PG8_BAR;
    if constexpr (Epi::AFTER_DRAIN) { E.fused(acc, cur, wr, wc, fr, fq, lds, wid, lane); S.done(cur); }
#undef PG8_SA
#undef PG8_SB
#undef PG8_STAGE
#undef PG8_LDA
#undef PG8_LDB
#undef PG8_MMA
#undef PG8_WAIT_V
#undef PG8_WAIT_L
#undef PG8_BAR
#undef PG8_SCHED
}
}

namespace att {
typedef unsigned short bf16;
using bf16x8 = __attribute__((ext_vector_type(8))) short;
using s16x4  = __attribute__((ext_vector_type(4))) short;
using f32x16 = __attribute__((ext_vector_type(16))) float;
using u32x4  = __attribute__((ext_vector_type(4))) unsigned;
constexpr int   D = 128, NW = 8, QBLK = 32, KVBLK = 64, LDQ = 1024, LDK = 256, LDO = 1024;
constexpr float SCALE = 0.088388347648318440f, THR = 8.f;
constexpr size_t SHM_V = KVBLK * D * 2, SHM_K = KVBLK * D * 2, SHM_ATTN = 2 * SHM_V + 2 * SHM_K + NW * 64 * 4;
#define KSWZ(row, colB) ((row) * 256 + ((colB) ^ (((row) & 7) << 4)))
#define SBAR() __builtin_amdgcn_sched_barrier(0)
__device__ __forceinline__ int crow(int r, int hi) { return (r & 3) + 8 * (r >> 2) + 4 * hi; }
__device__ __forceinline__ unsigned cvtpk(float lo, float hi) { unsigned r; asm volatile("v_cvt_pk_bf16_f32 %0, %1, %2" : "=v"(r) : "v"(lo), "v"(hi)); return r; }

__device__ __forceinline__ void partialSM(f32x16& p0, f32x16& p1, float& m_reg, float& mn, float& alpha) {
  constexpr float C = SCALE * 1.4426950408889634f;
  float pmax = p0[0];
#pragma unroll
  for (int r = 1; r < 16; ++r) pmax = fmaxf(pmax, p0[r]);
#pragma unroll
  for (int r = 0; r < 16; ++r) pmax = fmaxf(pmax, p1[r]);
  { auto rr = __builtin_amdgcn_permlane32_swap(__float_as_uint(pmax), __float_as_uint(pmax), false, false);
    pmax = fmaxf(__uint_as_float(rr[0]), __uint_as_float(rr[1])); }
  if (__builtin_expect(__all(pmax - m_reg <= THR / SCALE), 1)) { mn = m_reg; alpha = 1.f; }
  else { mn = fmaxf(m_reg, pmax); alpha = __builtin_amdgcn_exp2f((m_reg - mn) * C); m_reg = mn; }
  float mnC = -mn * C;
#pragma unroll
  for (int r = 0; r < 16; ++r) p0[r] = fmaf(p0[r], C, mnC);
#pragma unroll
  for (int r = 0; r < 16; ++r) p1[r] = fmaf(p1[r], C, mnC);
#pragma unroll
  for (int r = 0; r < 16; ++r) p0[r] = __builtin_amdgcn_exp2f(p0[r]);
}
__device__ __forceinline__ void finishSM(f32x16& p0, f32x16& p1, float alpha, float& l_reg, bf16x8& pa0, bf16x8& pa1, bf16x8& pa2, bf16x8& pa3) {
#pragma unroll
  for (int r = 0; r < 16; ++r) p1[r] = __builtin_amdgcn_exp2f(p1[r]);
  float ps = 0;
#pragma unroll
  for (int r = 0; r < 16; ++r) ps += p0[r];
#pragma unroll
  for (int r = 0; r < 16; ++r) ps += p1[r];
  { auto rr = __builtin_amdgcn_permlane32_swap(__float_as_uint(ps), __float_as_uint(ps), false, false);
    ps = __uint_as_float(rr[0]) + __uint_as_float(rr[1]); }
  l_reg = l_reg * alpha + ps;
#define PK4(P, BASE, OUT) do { unsigned a0 = cvtpk(P[BASE + 0], P[BASE + 1]), a1 = cvtpk(P[BASE + 2], P[BASE + 3]);   \
    unsigned b0 = cvtpk(P[BASE + 4], P[BASE + 5]), b1 = cvtpk(P[BASE + 6], P[BASE + 7]);                              \
    auto r0 = __builtin_amdgcn_permlane32_swap(a0, b0, false, false); auto r1 = __builtin_amdgcn_permlane32_swap(a1, b1, false, false); \
    u32x4 w = {r0[0], r1[0], r0[1], r1[1]}; OUT = *reinterpret_cast<bf16x8*>(&w); } while (0)
  PK4(p0, 0, pa0); PK4(p0, 8, pa1); PK4(p1, 0, pa2); PK4(p1, 8, pa3);
#undef PK4
}
__device__ __forceinline__ void qkt(f32x16& p0, f32x16& p1, const bf16* Ks, const bf16x8* qr, int r32, int hi, bool domask, int mbase) {
  if (domask) {
#pragma unroll
    for (int r = 0; r < 16; ++r) { const int c = (r & 3) + 8 * (r >> 2);
      p0[r] = ((unsigned)(mbase + c + 128) <= 256u) ? 0.f : -INFINITY; p1[r] = ((unsigned)(mbase + c + 32 + 128) <= 256u) ? 0.f : -INFINITY; }
  } else { p0 = f32x16{}; p1 = f32x16{}; }
#pragma unroll
  for (int d0 = 0; d0 < 8; ++d0) { int cb = (d0 * 16 + hi * 8) * 2;
    bf16x8 b0 = *reinterpret_cast<const bf16x8*>((const char*)Ks + KSWZ(r32, cb));
    bf16x8 b1 = *reinterpret_cast<const bf16x8*>((const char*)Ks + KSWZ(32 + r32, cb));
    p0 = __builtin_amdgcn_mfma_f32_32x32x16_bf16(b0, qr[d0], p0, 0, 0, 0);
    p1 = __builtin_amdgcn_mfma_f32_32x32x16_bf16(b1, qr[d0], p1, 0, 0, 0); }
}
__device__ __forceinline__ int v_st(int k, int c) { const int kk = (k & ~0xC) | ((k & 4) << 1) | ((k & 8) >> 1); return ((kk >> 3) * 4 + (c >> 5)) * 512 + ((kk & 7) * 32 + (c & 31)) * 2; }
__device__ __forceinline__ int v_rd_base(int lane) { return ((lane & 3) << 3) | (((lane >> 2) & 3) << 6) | (((lane >> 4) & 1) << 5) | (((lane >> 5) & 1) << 8); }
constexpr int v_rd_off(int d0, int ks, int half) { return d0 * 512 + ks * 4096 + half * 2048; }
template <int OFF> __device__ __forceinline__ s16x4 tr_read(int vb) {
  s16x4 r; asm volatile("ds_read_b64_tr_b16 %0, %1 offset:%2" : "=&v"(r) : "v"(vb), "i"(OFF) : "memory"); return r;
}
template <int D0> __device__ __forceinline__ void pv_one(f32x16& od, int vb, bf16x8 pa0, bf16x8 pa1, bf16x8 pa2, bf16x8 pa3) {
  const s16x4 l0 = tr_read<v_rd_off(D0, 0, 0)>(vb), h0 = tr_read<v_rd_off(D0, 0, 1)>(vb), l1 = tr_read<v_rd_off(D0, 1, 0)>(vb), h1 = tr_read<v_rd_off(D0, 1, 1)>(vb);
  const s16x4 l2 = tr_read<v_rd_off(D0, 2, 0)>(vb), h2 = tr_read<v_rd_off(D0, 2, 1)>(vb), l3 = tr_read<v_rd_off(D0, 3, 0)>(vb), h3 = tr_read<v_rd_off(D0, 3, 1)>(vb);
  asm volatile("s_waitcnt lgkmcnt(0)" ::: "memory"); SBAR();
#define PK(L, H) (bf16x8){L[0], L[1], L[2], L[3], H[0], H[1], H[2], H[3]}
  od = __builtin_amdgcn_mfma_f32_32x32x16_bf16(pa0, PK(l0, h0), od, 0, 0, 0);
  od = __builtin_amdgcn_mfma_f32_32x32x16_bf16(pa1, PK(l1, h1), od, 0, 0, 0);
  od = __builtin_amdgcn_mfma_f32_32x32x16_bf16(pa2, PK(l2, h2), od, 0, 0, 0);
  od = __builtin_amdgcn_mfma_f32_32x32x16_bf16(pa3, PK(l3, h3), od, 0, 0, 0);
#undef PK
}
__device__ __forceinline__ void pv_d0(f32x16* o, int vb, bf16x8 pa0, bf16x8 pa1, bf16x8 pa2, bf16x8 pa3) {
  pv_one<0>(o[0], vb, pa0, pa1, pa2, pa3); pv_one<1>(o[1], vb, pa0, pa1, pa2, pa3); pv_one<2>(o[2], vb, pa0, pa1, pa2, pa3); pv_one<3>(o[3], vb, pa0, pa1, pa2, pa3);
}

__device__ __forceinline__ void attn_body(const bf16* __restrict__ Qb, const bf16* __restrict__ Kl, const bf16* __restrict__ Vl, const bf16* __restrict__ Kc, const bf16* __restrict__ Vc,
                                          int NT, int nloc, bool masked, int kp0, int q0, float sink_l2, bf16* __restrict__ Ob, char* lds, int tid) {
  const int wid = tid >> 6, lane = tid & 63, r32 = lane & 31, hi = lane >> 5;
  bf16* V_lds = (bf16*)lds; bf16* K_lds = (bf16*)(lds + 2 * SHM_V);
  float* wsl = (float*)(lds + 2 * SHM_V + 2 * SHM_K) + wid * 64; float* li_l = wsl; float* al_l = wsl + 32;
  float m_reg = -1e30f, l_reg = 0; f32x16 o[4] = {}; bf16x8 qr[8];
  const bf16* Qw = Qb + (long)(wid * QBLK + r32) * LDQ + hi * 8;
#pragma unroll
  for (int d0 = 0; d0 < 8; ++d0) qr[d0] = *reinterpret_cast<const bf16x8*>(Qw + d0 * 16);
  const int sr = tid >> 4, sc = (tid & 15) * 8, vst0 = v_st(sr, sc), vst1 = v_st(32 + sr, sc);
  const int vb0 = (int)(uintptr_t)V_lds + v_rd_base(lane);
  const int mb0 = kp0 - (q0 + wid * QBLK + r32) + 4 * hi;
  struct { bf16x8 vs0, vs1, ks0, ks1; } sr_[2];
#define TILEK(j) ((j) < nloc ? Kl + (long)(j) * (KVBLK * LDK) : Kc + (long)((j) - nloc) * (KVBLK * LDK))
#define TILEV(j) ((j) < nloc ? Vl + (long)(j) * (KVBLK * LDK) : Vc + (long)((j) - nloc) * (KVBLK * LDK))
#define SLOAD(i, j) do { const bf16* kt_ = TILEK(j); const bf16* vt_ = TILEV(j); \
    sr_[i].vs0 = *reinterpret_cast<const bf16x8*>(&vt_[(long)(sr) * LDK + sc]); sr_[i].vs1 = *reinterpret_cast<const bf16x8*>(&vt_[(long)(32 + sr) * LDK + sc]); \
    sr_[i].ks0 = *reinterpret_cast<const bf16x8*>(&kt_[(long)(sr) * LDK + sc]); sr_[i].ks1 = *reinterpret_cast<const bf16x8*>(&kt_[(long)(32 + sr) * LDK + sc]); } while (0)
#define SWRITE(b, i) do { *(bf16x8*)((char*)V_lds + (b) * SHM_V + vst0) = sr_[i].vs0;          \
    *(bf16x8*)((char*)V_lds + (b) * SHM_V + vst1) = sr_[i].vs1; int kc = sc * 2;               \
    *(bf16x8*)((char*)K_lds + (b) * SHM_K + KSWZ(sr, kc)) = sr_[i].ks0;                       \
    *(bf16x8*)((char*)K_lds + (b) * SHM_K + KSWZ(32 + sr, kc)) = sr_[i].ks1; } while (0)
#define SWAIT() asm volatile("s_waitcnt vmcnt(4)" ::: "memory")
#define RESC(a) do { if (__any((a) < 1.f)) { if (hi == 0) al_l[r32] = (a); asm volatile("s_waitcnt lgkmcnt(0)" ::: "memory"); \
    _Pragma("unroll") for (int d = 0; d < 4; ++d) _Pragma("unroll") for (int r = 0; r < 16; ++r) o[d][r] *= al_l[crow(r, hi)]; } } while (0)
#define QKT(P0, P1, KS, j) qkt(P0, P1, KS, qr, r32, hi, masked && (j) < nloc, mb0 + 64 * (j))
  f32x16 pA0, pA1, pB0, pB1; float mnA, mnB, alA, alB; bf16x8 pa0, pa1, pa2, pa3;
  constexpr int SE = 0, SO = 1;
  SLOAD(SE, 0); asm volatile("s_waitcnt vmcnt(0)" ::: "memory"); SWRITE(0, SE); __syncthreads();
  QKT(pA0, pA1, K_lds, 0); partialSM(pA0, pA1, m_reg, mnA, alA);
  SLOAD(SO, 1); if (2 < NT) SLOAD(SE, 2);
  SWAIT(); SWRITE(1, SO); __syncthreads();
  for (int j = 1; j + 1 < NT; j += 2) {
    SBAR(); QKT(pB0, pB1, (bf16*)((char*)K_lds + SHM_K), j);
    finishSM(pA0, pA1, alA, l_reg, pa0, pa1, pa2, pa3); SBAR();
    SLOAD(SO, (j + 2 < NT ? j + 2 : NT - 1)); SBAR();
    pv_d0(o, vb0, pa0, pa1, pa2, pa3); partialSM(pB0, pB1, m_reg, mnB, alB);
    __syncthreads(); SWAIT(); SWRITE(0, SE);
    RESC(alB); __syncthreads();
    SBAR(); QKT(pA0, pA1, K_lds, j + 1);
    finishSM(pB0, pB1, alB, l_reg, pa0, pa1, pa2, pa3); SBAR();
    if (j + 3 < NT) SLOAD(SE, j + 3); SBAR();
    pv_d0(o, vb0 + (int)SHM_V, pa0, pa1, pa2, pa3); partialSM(pA0, pA1, m_reg, mnA, alA);
    __syncthreads(); SWAIT(); SWRITE(1, SO);
    RESC(alA); __syncthreads();
  }
  SBAR(); QKT(pB0, pB1, (bf16*)((char*)K_lds + SHM_K), NT - 1);
  finishSM(pA0, pA1, alA, l_reg, pa0, pa1, pa2, pa3); SBAR();
  pv_d0(o, vb0, pa0, pa1, pa2, pa3); partialSM(pB0, pB1, m_reg, mnB, alB);
  __syncthreads(); RESC(alB);
  finishSM(pB0, pB1, alB, l_reg, pa0, pa1, pa2, pa3); SBAR();
  pv_d0(o, vb0 + (int)SHM_V, pa0, pa1, pa2, pa3);
  l_reg += __builtin_amdgcn_exp2f(sink_l2 - m_reg * (SCALE * 1.4426950408889634f));
  if (hi == 0) li_l[r32] = l_reg; asm volatile("s_waitcnt lgkmcnt(0)" ::: "memory");
  float rli[16];
#pragma unroll
  for (int r = 0; r < 16; ++r) rli[r] = __builtin_amdgcn_rcpf(li_l[crow(r, hi)]);
  bf16* Ow = Ob + (long)(wid * QBLK) * LDO;
#pragma unroll
  for (int r = 0; r < 16; ++r) { int orow = crow(r, hi);
#pragma unroll
    for (int d0 = 0; d0 < 4; ++d0) { const float ov = o[d0][r] * rli[r]; Ow[(long)orow * LDO + d0 * 32 + r32] = (bf16)cvtpk(ov, ov); } }
  __syncthreads();
#undef TILEK
#undef TILEV
#undef SLOAD
#undef SWRITE
#undef SWAIT
#undef RESC
#undef QKT
}
#undef KSWZ
#undef SBAR
}

constexpr int DM = 2048, NPR = 8192, NSR = 2048, MT = 10240, IN_DIM = 6656, DFF = 8192;
constexpr float LN_EPS = 1e-5f, RMS_EPS = 1e-6f, DN_ALPHA = 1.681792830507429f, ATT_SCALE = 0.08838834764831845f;
constexpr size_t OUT_CK = 20971520, OUT_CV = 29360128, OUT_SF = 37748736, OUT_SB = 54525952;
constexpr size_t MiB = 1u << 20;
constexpr size_t WS_CTL = 0, CTL_ZERO_BYTES = 1 * MiB;
constexpr size_t WS_ROPE = 1 * MiB, WS_LB = 1 * MiB + 65536, WS_MODS = 2 * MiB;
constexpr size_t WS_WIN = 4 * MiB, WS_WO = 108 * MiB, WS_WUP = 140 * MiB, WS_WDN = 268 * MiB;
constexpr size_t WS_X = 396 * MiB, WS_Y = 476 * MiB, WS_H = 556 * MiB, WS_MIX = 596 * MiB, WS_ACT = 636 * MiB;
constexpr size_t WS_QB = 796 * MiB, WS_KB = 816 * MiB, WS_VB = 821 * MiB, WS_HQ = 826 * MiB, WS_HI = 846 * MiB, WS_HG = 866 * MiB;
constexpr size_t WS_ZF = 886 * MiB, WS_ZB = 926 * MiB, WS_OF = 966 * MiB, WS_OB = 1006 * MiB, WS_ATT = 1046 * MiB, WS_CKB = 1086 * MiB, WS_CVB = 1088 * MiB, WS_SL = 1090 * MiB, WS_END = 1250 * MiB;
constexpr int CW_BAR = 4096, CW_Q = 16384;
constexpr int RING_BYTES = 131072, LDS_BYTES = 163840, LDSCTL_OFF = LDS_BYTES - 512, MISC_OFF = LDSCTL_OFF + 320;

#define GAS __attribute__((address_space(1)))
#define LAS __attribute__((address_space(3)))
typedef unsigned short bf16;
typedef unsigned v4u __attribute__((ext_vector_type(4)));
typedef unsigned v2u __attribute__((ext_vector_type(2)));
typedef float f32x4 __attribute__((ext_vector_type(4)));
typedef float f32x2 __attribute__((ext_vector_type(2)));
typedef GAS unsigned gu32;
#define LDS_WAIT() asm volatile("s_waitcnt lgkmcnt(0)" ::: "memory")
__device__ __forceinline__ unsigned f2bf(float f) { unsigned u = __builtin_bit_cast(unsigned, f); return (u + 0x7fffu + ((u >> 16) & 1u)) >> 16; }
__device__ __forceinline__ unsigned pk2(float lo, float hi) { return f2bf(lo) | (f2bf(hi) << 16); }
__device__ __forceinline__ float bflo(unsigned w) { return __builtin_bit_cast(float, w << 16); }
__device__ __forceinline__ float bfhi(unsigned w) { return __builtin_bit_cast(float, w & 0xffff0000u); }
__device__ __forceinline__ float bf2f(bf16 b) { return __builtin_bit_cast(float, ((unsigned)b) << 16); }
__device__ __forceinline__ float siluf(float x) { return x * __builtin_amdgcn_rcpf(1.f + __expf(-x)); }


namespace hg {
typedef unsigned short bf16;
using bf16x8 = __attribute__((ext_vector_type(8))) short;
using bf16x4 = __attribute__((ext_vector_type(4))) short;
using f32x16 = __attribute__((ext_vector_type(16))) float;
constexpr int QS = 136, TS = 40;
constexpr int OFF_QT = 0, OFF_KT = 8704, OFF_KTT = 17408, OFF_EMID = 27648, OFF_ELM = 28160, OFF_VT = 28672, VT_BYTES = 2560, BUF_BYTES = 38912;
constexpr int HG_LDS_BYTES = 4 * BUF_BYTES;
__device__ __forceinline__ int crow(int r, int hi) { return (r & 3) + 8 * (r >> 2) + 4 * hi; }
__device__ __forceinline__ unsigned cvtpk(float lo, float hi) { unsigned r; asm volatile("v_cvt_pk_bf16_f32 %0, %1, %2" : "=v"(r) : "v"(lo), "v"(hi)); return r; }
__device__ __forceinline__ unsigned f2bfc(float f) { unsigned u = __builtin_bit_cast(unsigned, f); return (u + 0x7fffu + ((u >> 16) & 1u)) >> 16; }
__device__ __forceinline__ unsigned pk2c(float lo, float hi) { return f2bfc(lo) | (f2bfc(hi) << 16); }
__device__ __forceinline__ bf16x8 pack8(const f32x16& x, int b) {
  typedef unsigned u32x4 __attribute__((ext_vector_type(4)));
  u32x4 w = {cvtpk(x[b + 0], x[b + 1]), cvtpk(x[b + 2], x[b + 3]), cvtpk(x[b + 4], x[b + 5]), cvtpk(x[b + 6], x[b + 7])}; return __builtin_bit_cast(bf16x8, w);
}
__device__ __forceinline__ bf16x8 cat4(bf16x4 a, bf16x4 b) { return (bf16x8){a[0], a[1], a[2], a[3], b[0], b[1], b[2], b[3]}; }

__device__ __forceinline__ void gates_to_lds(LAS unsigned char* buf, const float (&zr)[16], const bf16 (&qr)[16], bf16x8 va, bf16x8 vb, float lbv, float olb, int dkg, int half, int js, int r32, int hi) {
  LAS bf16* Qt = (LAS bf16*)(buf + OFF_QT); LAS bf16* Kt = (LAS bf16*)(buf + OFF_KT); LAS bf16* KtT = (LAS bf16*)(buf + OFF_KTT);
  LAS float* emid = (LAS float*)(buf + OFF_EMID); LAS float* elm = (LAS float*)(buf + OFF_ELM); LAS bf16* Vt = (LAS bf16*)(buf + OFF_VT + js * VT_BYTES);
  float fz[16], kz[16], qv[16];
#pragma unroll
  for (int ii = 0; ii < 16; ++ii) { const float z = zr[ii]; qv[ii] = __builtin_bit_cast(float, ((unsigned)qr[ii]) << 16);
    const float e = __expf(-fmaxf(z, -80.f)), rr = __builtin_amdgcn_rcpf(1.f + e); fz[ii] = (1.f + lbv * e) * rr; kz[ii] = olb * e * rr; }
  unsigned kw[8];
  if (half) { float E = 1.f;
#pragma unroll
    for (int ii = 0; ii < 16; ++ii) { E = fmaxf(E * fz[ii], 1e-30f); const float qt = qv[ii] * E, kt = kz[ii] * __builtin_amdgcn_rcpf(E);
      const unsigned qb = cvtpk(qt, qt), kb = cvtpk(kt, kt); Qt[(16 + ii) * QS + dkg] = (bf16)qb; Kt[(16 + ii) * QS + dkg] = (bf16)kb;
      if (ii & 1) kw[ii >> 1] |= kb << 16; else kw[ii >> 1] = kb & 0xffffu; }
    elm[dkg] = E;
  } else { float Dd = 1.f;
#pragma unroll
    for (int ii = 15; ii >= 0; --ii) { const float qt = qv[ii] * __builtin_amdgcn_rcpf(Dd), kt = kz[ii] * Dd;
      const unsigned qb = cvtpk(qt, qt), kb = cvtpk(kt, kt); Qt[ii * QS + dkg] = (bf16)qb; Kt[ii * QS + dkg] = (bf16)kb;
      if (ii & 1) kw[ii >> 1] = kb << 16; else kw[ii >> 1] |= kb & 0xffffu;
      Dd = fmaxf(Dd * fz[ii], 1e-30f); }
    emid[dkg] = Dd;
  }
  typedef unsigned u32x4 __attribute__((ext_vector_type(4)));
  LAS u32x4* kd = (LAS u32x4*)(KtT + dkg * TS + 16 * half);
  kd[0] = (u32x4){kw[0], kw[1], kw[2], kw[3]}; kd[1] = (u32x4){kw[4], kw[5], kw[6], kw[7]};
#pragma unroll
  for (int e = 0; e < 8; ++e) { Vt[(16 * hi + e) * TS + r32] = (bf16)va[e]; Vt[(16 * hi + 8 + e) * TS + r32] = (bf16)vb[e]; }
}

__device__ __forceinline__ f32x16 chunk_mfma(LAS unsigned char* buf, f32x16 (&S)[4], int js, int r32, int hi) {
  const LAS bf16* Qt = (const LAS bf16*)(buf + OFF_QT); const LAS bf16* Kt = (const LAS bf16*)(buf + OFF_KT); const LAS bf16* KtT = (const LAS bf16*)(buf + OFF_KTT);
  const LAS float* emid = (const LAS float*)(buf + OFF_EMID); const LAS float* elm = (const LAS float*)(buf + OFF_ELM); const LAS bf16* Vt = (const LAS bf16*)(buf + OFF_VT + js * VT_BYTES);
  bf16x8 Sb[4][2];
#pragma unroll
  for (int Tt = 0; Tt < 4; ++Tt) {
#pragma unroll
    for (int qd = 0; qd < 4; ++qd) { const f32x4 em = *(const LAS f32x4*)(emid + 32 * Tt + 8 * qd + 4 * hi);
#pragma unroll
      for (int e = 0; e < 4; ++e) S[Tt][4 * qd + e] *= em[e]; }
    Sb[Tt][0] = pack8(S[Tt], 0); Sb[Tt][1] = pack8(S[Tt], 8); }
  f32x16 AT = {}, oT = {};
#pragma unroll
  for (int hb = 0; hb < 2; ++hb) { bf16x8 ka[4], qb[4], qp[2][2];
#pragma unroll
    for (int st = 0; st < 4; ++st) { ka[st] = *(const LAS bf16x8*)(Kt + r32 * QS + 16 * (4 * hb + st) + 8 * hi); qb[st] = *(const LAS bf16x8*)(Qt + r32 * QS + 16 * (4 * hb + st) + 8 * hi); }
#pragma unroll
    for (int t2 = 0; t2 < 2; ++t2)
#pragma unroll
      for (int s2 = 0; s2 < 2; ++s2) { const LAS bf16* qr = Qt + r32 * QS + 32 * (2 * hb + t2) + 16 * s2 + 4 * hi; qp[t2][s2] = cat4(*(const LAS bf16x4*)(qr), *(const LAS bf16x4*)(qr + 8)); }
#pragma unroll
    for (int j = 0; j < 4; ++j) { AT = __builtin_amdgcn_mfma_f32_32x32x16_bf16(ka[j], qb[j], AT, 0, 0, 0);
      oT = __builtin_amdgcn_mfma_f32_32x32x16_bf16(Sb[2 * hb + (j >> 1)][j & 1], qp[j >> 1][j & 1], oT, 0, 0, 0); } }
  { const bf16x8 v0 = *(const LAS bf16x8*)(Vt + r32 * TS + 8 * hi), v1 = *(const LAS bf16x8*)(Vt + r32 * TS + 16 + 8 * hi);
    bf16x8 kf[4][2];
#pragma unroll
    for (int Tt = 0; Tt < 4; ++Tt) { const LAS bf16* kr = KtT + (32 * Tt + r32) * TS + 8 * hi; kf[Tt][0] = *(const LAS bf16x8*)(kr); kf[Tt][1] = *(const LAS bf16x8*)(kr + 16); }
#pragma unroll
    for (int Tt = 0; Tt < 4; ++Tt) S[Tt] = __builtin_amdgcn_mfma_f32_32x32x16_bf16(kf[Tt][0], v0, S[Tt], 0, 0, 0);
#pragma unroll
    for (int Tt = 0; Tt < 4; ++Tt) S[Tt] = __builtin_amdgcn_mfma_f32_32x32x16_bf16(kf[Tt][1], v1, S[Tt], 0, 0, 0); }
#pragma unroll
  for (int r = 0; r < 16; ++r) AT[r] = (crow(r, hi) <= r32) ? AT[r] : 0.f;
  { const bf16x8 Pb0 = pack8(AT, 0), Pb1 = pack8(AT, 8); const LAS bf16* vr = Vt + r32 * TS + 4 * hi;
    const bf16x8 v0 = cat4(*(const LAS bf16x4*)(vr), *(const LAS bf16x4*)(vr + 8)), v1 = cat4(*(const LAS bf16x4*)(vr + 16), *(const LAS bf16x4*)(vr + 24));
    oT = __builtin_amdgcn_mfma_f32_32x32x16_bf16(v0, Pb0, oT, 0, 0, 0);
    oT = __builtin_amdgcn_mfma_f32_32x32x16_bf16(v1, Pb1, oT, 0, 0, 0); }
#pragma unroll
  for (int Tt = 0; Tt < 4; ++Tt)
#pragma unroll
    for (int qd = 0; qd < 4; ++qd) { const f32x4 el = *(const LAS f32x4*)(elm + 32 * Tt + 8 * qd + 4 * hi);
#pragma unroll
      for (int e = 0; e < 4; ++e) S[Tt][4 * qd + e] *= el[e]; }
  return oT;
}

__device__ __forceinline__ void hgrn_body(LAS unsigned char* base, int tid, int wave, const float* __restrict__ Z, const bf16* __restrict__ HQ, const bf16* __restrict__ HI,
                                          bf16* __restrict__ O, const float* __restrict__ lb, const float* __restrict__ s_in, float* __restrict__ s_out, int row0, int T, int hcol, int dir) {
  const int lane = tid & 63, role = wave >> 2, js = wave & 3, r32 = lane & 31, hi = lane >> 5;
  const int nch = T >> 5;
#define HG_BAR() asm volatile("s_waitcnt lgkmcnt(0)\n\ts_barrier" ::: "memory")
  if (role) {
    const int lt = tid & 255, dkg = lt & 127, half = (wave >> 1) & 1;
    const float lbv = lb[dkg], olb = 1.f - lbv;
    float zr[16]; bf16 qr[16]; bf16x8 va, vb;
#define HG_LOAD(nn) do { _Pragma("unroll") for (int ii = 0; ii < 16; ++ii) { const int i_ = 32 * (nn) + 16 * half + ii, t_ = dir ? T - 1 - i_ : i_; const size_t off_ = (size_t)(row0 + t_) * 1024 + hcol + dkg; \
      zr[ii] = Z[off_]; qr[ii] = HQ[off_]; } \
    { const int i_ = 32 * (nn) + r32, t_ = dir ? T - 1 - i_ : i_; const bf16* src_ = HI + (size_t)(row0 + t_) * 1024 + hcol + 32 * js + 16 * hi; va = *(const bf16x8*)src_; vb = *(const bf16x8*)(src_ + 8); } } while (0)
    HG_LOAD(0);
    gates_to_lds(base, zr, qr, va, vb, lbv, olb, dkg, half, js, r32, hi);
    HG_LOAD(nch > 1 ? 1 : 0);
    HG_BAR();
    for (int n = 0; n < nch; ++n) {
      if (n + 1 < nch) gates_to_lds(base + ((n + 1) & 1) * BUF_BYTES, zr, qr, va, vb, lbv, olb, dkg, half, js, r32, hi);
      { const int nn = n + 2 < nch ? n + 2 : nch - 1; HG_LOAD(nn); }
      HG_BAR();
    }
#undef HG_LOAD
  } else {
    f32x16 S[4];
#pragma unroll
    for (int Tt = 0; Tt < 4; ++Tt)
#pragma unroll
      for (int r = 0; r < 16; ++r) S[Tt][r] = s_in ? s_in[(size_t)(32 * Tt + crow(r, hi)) * 128 + 32 * js + r32] : 0.f;
    HG_BAR();
    for (int n = 0; n < nch; ++n) {
      const f32x16 oT = chunk_mfma(base + (n & 1) * BUF_BYTES, S, js, r32, hi);
      { const int i = 32 * n + r32, t = dir ? T - 1 - i : i; bf16* op = O + (size_t)(row0 + t) * 1024 + hcol + 32 * js + 4 * hi; typedef unsigned u32x2_t __attribute__((ext_vector_type(2)));
#pragma unroll
        for (int qd = 0; qd < 4; ++qd) { u32x2_t w; w.x = pk2c(oT[4 * qd], oT[4 * qd + 1]); w.y = pk2c(oT[4 * qd + 2], oT[4 * qd + 3]);     *(u32x2_t*)(op + 8 * qd) = w; } }
      HG_BAR();
    }
    if (s_out) {
#pragma unroll
      for (int Tt = 0; Tt < 4; ++Tt)
#pragma unroll
        for (int r = 0; r < 16; ++r) s_out[(size_t)(32 * Tt + crow(r, hi)) * 128 + 32 * js + r32] = S[Tt][r];
    }
  }
#undef HG_BAR
}
}
#define XB_TMO      128
#define XB_XCNT(j)  (256  + 64 * (j))
#define XB_XSUB(j)  (1280 + 64 * (j))
#define XB_XGEN(j)  (2304 + 64 * (j))
#define XB_TOP      3328
#define XB_TOPGEN   3392
#define XCD_BAR_WORDS 3456
#define XB_SPIN_CAP (1u << 18)
__device__ __forceinline__ unsigned xb_ld(unsigned* p)              { return __hip_atomic_load(p, __ATOMIC_RELAXED, __HIP_MEMORY_SCOPE_AGENT); }
__device__ __forceinline__ unsigned xb_add(unsigned* p, unsigned v) { return __hip_atomic_fetch_add(p, v, __ATOMIC_RELAXED, __HIP_MEMORY_SCOPE_AGENT); }
__device__ __forceinline__ unsigned xb_xcc_id() { return (unsigned)__builtin_amdgcn_s_getreg((3 << 11) | 20) & 0xFu; }
#define XB_SPIN(cond, bar) do { unsigned _sp = 0; while (cond) { __builtin_amdgcn_s_sleep(1); \
    if ((++_sp & 255u) == 0u) { if (xb_ld(&(bar)[XB_TMO])) break; if (_sp > XB_SPIN_CAP) { atomicAdd(&(bar)[XB_TMO], 1u); break; } } } } while (0)
struct XcdBarrier { unsigned* bar; unsigned x; volatile LAS unsigned* st; };
__device__ __forceinline__ XcdBarrier xcd_barrier_post(unsigned* bar, volatile LAS unsigned* st) {
    XcdBarrier b; b.bar = bar; b.x = xb_xcc_id(); b.st = st;
    if (threadIdx.x == 0) (void)xb_add(&bar[XB_XCNT(b.x)], 1u);
    return b;
}
__device__ __forceinline__ void xcd_barrier_complete(unsigned* bar, unsigned x, unsigned& nloc, unsigned& nx) {
    const unsigned G = gridDim.x * gridDim.y * gridDim.z;
    unsigned sum, cnt, mine, sp = 0u;
    for (;;) {
        sum = 0u; cnt = 0u; mine = 0u;
#pragma unroll
        for (unsigned j = 0; j < 16; ++j) { const unsigned c = xb_ld(&bar[XB_XCNT(j)]); sum += c; cnt += (c > 0u) ? 1u : 0u; mine = (j == x) ? c : mine; }
        if (sum == G) break;
        __builtin_amdgcn_s_sleep(1);
        if ((++sp & 255u) == 0u) { if (xb_ld(&bar[XB_TMO])) break; if (sp > XB_SPIN_CAP) { atomicAdd(&bar[XB_TMO], 1u); break; } }
    }
    nloc = mine > 0u ? mine : 1u; nx = cnt > 0u ? cnt : 1u;
}
__device__ __forceinline__ void xcd_barrier(const XcdBarrier& b) {
    asm volatile("s_waitcnt vmcnt(0)" ::: "memory");
    __syncthreads();
    if (threadIdx.x == 0) {
        unsigned* bar = b.bar;
        __builtin_amdgcn_s_waitcnt(0);
        unsigned nloc = b.st[0], nx = b.st[1];
        if (nloc == 0u) { xcd_barrier_complete(bar, b.x, nloc, nx); b.st[0] = nloc; b.st[1] = nx; }
        const unsigned old = xb_add(&bar[XB_XSUB(b.x)], 1u);
        const unsigned gen = old / nloc;
        if (old + 1u == (gen + 1u) * nloc) {
            __builtin_amdgcn_fence(__ATOMIC_RELEASE, "agent");
            asm volatile("s_waitcnt vmcnt(0)" ::: "memory");
            const unsigned og = xb_add(&bar[XB_TOP], 1u);
            const unsigned tg = og / nx;
            if (og + 1u == (tg + 1u) * nx) xb_add(&bar[XB_TOPGEN], 1u);
            else XB_SPIN(xb_ld(&bar[XB_TOPGEN]) == tg, bar);
            __builtin_amdgcn_fence(__ATOMIC_ACQUIRE, "agent");
            xb_add(&bar[XB_XGEN(b.x)], 1u);
            asm volatile("s_waitcnt vmcnt(0)" ::: "memory");
        } else {
            XB_SPIN(xb_ld(&bar[XB_XGEN(b.x)]) == gen, bar);
            __builtin_amdgcn_fence(__ATOMIC_ACQUIRE, "agent");
            asm volatile("s_waitcnt vmcnt(0)" ::: "memory");
        }
    }
    __syncthreads();
}

struct Args { const float* in[20]; float* out; unsigned char* ws; };
typedef const __attribute__((address_space(4))) Args* KArgs;
#define GIN(i) ((const float*)(const GAS float*)(A->in[i]))
struct Frame { LAS unsigned char* lds; unsigned* ctl; unsigned char* ws; float* out; int tid, lane, wave, vcu, G; };

__device__ __forceinline__ float wave_sum(float v) {
#pragma unroll
    for (int o = 1; o < 64; o <<= 1) v += __shfl_xor(v, o);
    return v;
}
__device__ __forceinline__ float wave_max(float v) {
#pragma unroll
    for (int o = 1; o < 64; o <<= 1) v = fmaxf(v, __shfl_xor(v, o));
    return v;
}

__host__ __device__ __forceinline__ int rope_col(int d) { return (d & 64) | ((d & 31) << 1) | ((d >> 5) & 1); }
template <bool QKPERM>
__device__ __forceinline__ void p0_transpose_item(const float* W, int K, int N, bf16* WT, LAS float* scr, int item, int lane) {
    const int nblk = N / 32, kb = item / nblk, nb = item % nblk, k0 = 64 * kb, n0 = 32 * nb;
    float v[32];
#pragma unroll
    for (int i = 0; i < 32; ++i) { const int kk = 2 * i + (lane >> 5); v[i] = W[(size_t)(k0 + kk) * N + n0 + (lane & 31)]; }
#pragma unroll
    for (int i = 0; i < 32; ++i) { const int kk = 2 * i + (lane >> 5); scr[kk * 33 + (lane & 31)] = v[i]; }
    LDS_WAIT(); asm volatile("" ::: "memory");
    const int c = lane & 7;
#pragma unroll
    for (int j = 0; j < 4; ++j) { const int n = (lane >> 3) + 8 * j; const LAS float* s = scr + (8 * c) * 33 + n;
        v4u o; o.x = pk2(s[0 * 33], s[1 * 33]); o.y = pk2(s[2 * 33], s[3 * 33]); o.z = pk2(s[4 * 33], s[5 * 33]); o.w = pk2(s[6 * 33], s[7 * 33]);
        int nr = n0 + n; if (QKPERM && nr < 1280) nr = (nr & ~127) | rope_col(nr & 127);
        *(GAS v4u*)(WT + (size_t)nr * K + k0 + 8 * c) = o; }
    LDS_WAIT(); asm volatile("" ::: "memory");
}

__device__ __forceinline__ void mods_item(const Frame& F, KArgs A, const LAS float* sil, int mi) {
    const int l = mi / 96, cb = mi % 96; const int c4 = (F.lane & 31) * 4, kh = F.lane >> 5;
    const float* W = GIN(8) + (size_t)l * 2048 * 12288 + cb * 128 + c4;
    f32x4 a0 = {0.f, 0.f, 0.f, 0.f}, a1 = a0, a2 = a0;
    const float* Wp = W + (size_t)kh * 12288;
    for (int i0 = 0; i0 < 1024; i0 += 16) {
        f32x4 w[16];
#pragma unroll
        for (int j = 0; j < 16; ++j) w[j] = *(const f32x4*)(Wp + (size_t)(2 * j) * 12288);
        Wp += (size_t)32 * 12288;
#pragma unroll
        for (int j = 0; j < 16; ++j) { const int k = 2 * (i0 + j) + kh; a0 += sil[k] * w[j]; a1 += sil[2048 + k] * w[j]; a2 += sil[4096 + k] * w[j]; }
    }
#pragma unroll
    for (int e = 0; e < 4; ++e) { a0[e] += __shfl_xor(a0[e], 32); a1[e] += __shfl_xor(a1[e], 32); a2[e] += __shfl_xor(a2[e], 32); }
    if (F.lane < 32) {
        const f32x4 bias = *(const f32x4*)(GIN(9) + l * 12288 + cb * 128 + c4);
        float* M = (float*)(F.ws + WS_MODS) + (size_t)(l * 3) * 12288 + cb * 128 + c4;
        *(f32x4*)(M) = a0 + bias; *(f32x4*)(M + 12288) = a1 + bias; *(f32x4*)(M + 2 * 12288) = a2 + bias;
    }
}

__device__ __forceinline__ void p0_prologue(const Frame& F, KArgs A) {
    LAS float* sil = (LAS float*)(F.lds + 73728);
    for (int e = F.tid; e < 3 * 2048; e += 512) { const int j = e >> 11, k = e & 2047; const float c = (j == 0) ? GIN(7)[k] : GIN(6)[(j - 1) * 2048 + k]; sil[e] = c / (1.f + __expf(-c)); }
    __syncthreads();
    for (int mi = F.vcu + F.G * F.wave; mi < 384; mi += F.G * 8) mods_item(F, A, sil, mi);
    if (blockIdx.x == 0) {
        float* rope = (float*)(F.ws + WS_ROPE);
        for (int e = F.tid; e < 80 * 32; e += 512) { const int p = e >> 5, i = e & 31; const int pos = p < 16 ? p : p - 16;
            const float inv = exp2f(-(float)i * (13.287712379549449f / 32.f)); const float ang = (float)pos * inv;
            rope[2 * e] = cosf(ang); rope[2 * e + 1] = sinf(ang); }
        float* LB = (float*)(F.ws + WS_LB);
        for (int e = F.tid; e < 2048; e += 512) { const int dir = e >> 10, j = e & 1023; const float* lg = GIN(13) + (size_t)dir * 4096 + j;
            const float x0 = lg[0], x1 = lg[1024], x2 = lg[2048], x3 = lg[3072]; const float m = fmaxf(fmaxf(x0, x1), fmaxf(x2, x3));
            const float e0 = expf(x0 - m), e1 = expf(x1 - m), e2 = expf(x2 - m), e3 = expf(x3 - m); const float is = 1.f / (e0 + e1 + e2 + e3);
            float* o = LB + (size_t)dir * 4096 + j; o[0] = 0.f; o[1024] = e1 * is; o[2048] = (e1 + e2) * is; o[3072] = (e1 + e2 + e3) * is; }
    }
    {
        const int gt = F.vcu * 512 + F.tid, NGT = F.G * 512;
        for (int i = gt; i < 2 * 131072; i += NGT) { const bool isk = i < 131072; const int j = isk ? i : i - 131072; const float* src = (isk ? GIN(2) : GIN(3)) + (size_t)j * 8;
            const f32x4 x0 = *(const f32x4*)src, x1 = *(const f32x4*)(src + 4);
            if (isk) {
                bf16* dst = (bf16*)(F.ws + WS_CKB) + (((size_t)j * 8) & ~(size_t)127) + rope_col((j * 8) & 127);
                dst[0] = (bf16)f2bf(x0[0]); dst[2] = (bf16)f2bf(x0[1]); dst[4] = (bf16)f2bf(x0[2]); dst[6] = (bf16)f2bf(x0[3]);
                dst[8] = (bf16)f2bf(x1[0]); dst[10] = (bf16)f2bf(x1[1]); dst[12] = (bf16)f2bf(x1[2]); dst[14] = (bf16)f2bf(x1[3]);
            } else { v4u o; o.x = pk2(x0[0], x0[1]); o.y = pk2(x0[2], x0[3]); o.z = pk2(x1[0], x1[1]); o.w = pk2(x1[2], x1[3]); *(v4u*)((bf16*)(F.ws + WS_CVB) + (size_t)j * 8) = o; } }
    }
    LAS float* scr = (LAS float*)(F.lds + F.wave * 8704);
    const int gw = F.vcu * 8 + F.wave, NGW = F.G * 8;
    constexpr int I_IN = 32 * 208, I_O = 32 * 64, I_UP = 32 * 256, I_DN = 128 * 64, I_L = I_IN + I_O + I_UP + I_DN;
    for (int it = gw; it < 4 * I_L; it += NGW) {
        const int l = it / I_L; int r = it % I_L;
        if (r < I_IN) { p0_transpose_item<true>(GIN(10) + (size_t)l * 2048 * 6656, 2048, 6656, (bf16*)(F.ws + WS_WIN) + (size_t)l * 6656 * 2048, scr, r, F.lane); continue; } r -= I_IN;
        if (r < I_O) { p0_transpose_item<false>(GIN(15) + (size_t)l * 2048 * 2048, 2048, 2048, (bf16*)(F.ws + WS_WO) + (size_t)l * 2048 * 2048, scr, r, F.lane); continue; } r -= I_O;
        if (r < I_UP) { p0_transpose_item<false>(GIN(18) + (size_t)l * 2048 * 8192, 2048, 8192, (bf16*)(F.ws + WS_WUP) + (size_t)l * 8192 * 2048, scr, r, F.lane); continue; } r -= I_UP;
        { const int kb = r >> 6, nb = r & 63, ks = kb >> 5;
          p0_transpose_item<false>(GIN(19) + ((size_t)l * 8192 + (size_t)ks * 2048) * 2048, 2048, 2048, (bf16*)(F.ws + WS_WDN) + ((size_t)l * 4 + ks) * 2048 * 2048, scr, (kb & 31) * 64 + nb, F.lane); }
    }
}

__device__ __forceinline__ int cond_of_row(int r) { return r < NPR ? 0 : 1 + ((r - NPR) >> 10); }

__device__ __forceinline__ void modulate0_phase(const Frame& F, KArgs A) {
    const int gw = F.vcu * 8 + F.wave, NGW = F.G * 8; const float* MODS = (const float*)(F.ws + WS_MODS); bf16* H = (bf16*)(F.ws + WS_H);
    for (int r = gw; r < MT; r += NGW) {
        const float* xr = r < NPR ? GIN(0) + (size_t)r * DM : GIN(1) + (size_t)(r - NPR) * DM; const float* md = MODS + (size_t)cond_of_row(r) * 12288;
#pragma unroll
        for (int j = 0; j < 8; ++j) { const int c = (F.lane + 64 * j) * 4; const f32x4 x = *(const f32x4*)(xr + c), sc = *(const f32x4*)(md + 2048 + c), sh = *(const f32x4*)(md + c);
            const f32x4 h = x * (1.f + sc) + sh; v2u o; o.x = pk2(h[0], h[1]); o.y = pk2(h[2], h[3]); *(v2u*)(H + (size_t)r * DM + c) = o; }
    }
}

__device__ __forceinline__ void ln_phase(const Frame& F, KArgs A, int l, int which, int r_begin, int r_end, int gw, int NGW) {
    const float* MODS = (const float*)(F.ws + WS_MODS); bf16* H = (bf16*)(F.ws + WS_H);
    const float* Y = (const float*)(F.ws + WS_Y); const bool last = (which == 1 && l == 3); float* X = last ? F.out : (float*)(F.ws + WS_X);
    const float* lg = GIN(16) + (size_t)(l * 2 + which) * DM; const float* lb = GIN(17) + (size_t)(l * 2 + which) * DM;
    for (int r = r_begin + gw; r < r_end; r += NGW) {
        const float* yr = (which == 1 ? (const float*)(F.ws + WS_X) : Y) + (size_t)r * DM; f32x4 v[8]; float s = 0.f;
#pragma unroll
        for (int j = 0; j < 8; ++j) { v[j] = *(const f32x4*)(yr + (F.lane + 64 * j) * 4);
            if (which == 1) {
                v[j] = v[j] * DN_ALPHA;
                const bf16* sl = (const bf16*)(F.ws + WS_SL) + (size_t)r * DM + (F.lane + 64 * j) * 4;
#pragma unroll
                for (int k = 0; k < 4; ++k) { const v2u w = *(const v2u*)(sl + (size_t)k * MT * DM); v[j][0] += bflo(w.x); v[j][1] += bfhi(w.x); v[j][2] += bflo(w.y); v[j][3] += bfhi(w.y); } }
            s += (v[j][0] + v[j][1]) + (v[j][2] + v[j][3]); }
        const float mean = wave_sum(s) * (1.f / DM); float s2 = 0.f;
#pragma unroll
        for (int j = 0; j < 8; ++j) { v[j] = v[j] - mean; s2 += (v[j][0] * v[j][0] + v[j][1] * v[j][1]) + (v[j][2] * v[j][2] + v[j][3] * v[j][3]); }
        const float rstd = 1.f / sqrtf(wave_sum(s2) * (1.f / DM) + LN_EPS);
        const int cond = cond_of_row(r);
        const float* msc = which == 0 ? MODS + (size_t)(l * 3 + cond) * 12288 + 8192 : MODS + (size_t)((l + 1) * 3 + cond) * 12288 + 2048;
        const float* msh = which == 0 ? MODS + (size_t)(l * 3 + cond) * 12288 + 6144 : MODS + (size_t)((l + 1) * 3 + cond) * 12288;
#pragma unroll
        for (int j = 0; j < 8; ++j) { const int c = (F.lane + 64 * j) * 4; const f32x4 g = *(const f32x4*)(lg + c), b = *(const f32x4*)(lb + c);
            const f32x4 x = v[j] * rstd * g + b; *(f32x4*)(X + (size_t)r * DM + c) = x;
            if (!last) { const f32x4 sc = *(const f32x4*)(msc + c), sh = *(const f32x4*)(msh + c); const f32x4 h = x * (1.f + sc) + sh;
                v2u o; o.x = pk2(h[0], h[1]); o.y = pk2(h[2], h[3]); *(v2u*)(H + (size_t)r * DM + c) = o; } }
    }
}

namespace pg8 {
__device__ __forceinline__ void tile_of(int wgid, int nM, int nN, int& pm, int& pn) {
    const int nig = WGM * nN, gid = wgid / nig, fm = gid * WGM, gsz = (nM - fm) < WGM ? (nM - fm) : WGM;
    pm = fm + ((wgid % nig) % gsz); pn = (wgid % nig) / gsz;
}
struct InOrder {
    int G, c;
    __device__ __forceinline__ bool next(int i, Unit& u) const {
        const int L = i * G + c; if (L >= 1024) return false;
        const int wgid = (L & 7) * 128 + (L >> 3);
        if (wgid < 880) tile_of(wgid, 40, 22, u.pm, u.pn); else { tile_of(wgid - 880, 36, 4, u.pm, u.pn); u.pn += 22; }
        u.ks = 0; return true;
    }
    __device__ __forceinline__ void a_ready(const Unit&) const {}
    __device__ __forceinline__ void done(const Unit&) const {}
};
struct OneUnit {
    int pm, pn;
    __device__ __forceinline__ bool next(int i, Unit& u) const { if (i) return false; u.pm = pm; u.pn = pn; u.ks = 0; return true; }
    __device__ __forceinline__ void a_ready(const Unit&) const {}
    __device__ __forceinline__ void done(const Unit&) const {}
};
struct SplitOrder : StaticOrder {
    __device__ __forceinline__ bool next(int i, Unit& u) const { if (!StaticOrder::next(i, u)) return false; u.ks = u.pn >> 3; u.pn &= 7; return true; }
};
struct EpiIn {
    static constexpr bool PERM = true, AFTER_DRAIN = false;
    bf16_t *Q, *KB, *VB, *HQ, *HI, *HG; float *ZF, *ZB, *outK, *outV; const float* rope;
    __device__ __forceinline__ void operator()(const f32x4 (&acc)[2][2][4][2], const Unit& u, int wr, int wc, int fr, int fq) const {
        const int pn = u.pn, rbase = u.pm * BM + wr * 64 + fr, cl = wc * 32 + 8 * fq;
        if (pn >= 10 && pn < 18) {
            float* dst = (pn < 14 ? ZF + (pn - 10) * 256 : ZB + (pn - 14) * 256) + cl;
#pragma unroll
            for (int ai = 0; ai < 2; ++ai)
#pragma unroll
                for (int m = 0; m < 4; ++m) { float* rowp = dst + (size_t)(rbase + ai * HALF + m * 16) * 1024;
#pragma unroll
                    for (int bj = 0; bj < 2; ++bj) { *(f32x4*)(rowp + bj * HALF) = acc[ai][bj][m][0]; *(f32x4*)(rowp + bj * HALF + 4) = acc[ai][bj][m][1]; } }
        } else {
            bf16_t* dst; int ld = 1024; bool act = false; float* of = nullptr;
            if (pn < 4) dst = Q + pn * 256;
            else if (pn == 4) { dst = KB; ld = 256; of = outK; }
            else if (pn == 5) { dst = VB; ld = 256; of = outV; }
            else if (pn < 10) { dst = HQ + (pn - 6) * 256; act = true; }
            else if (pn < 22) dst = HI + (pn - 18) * 256;
            else { dst = HG + (pn - 22) * 256; act = true; }
            if (u.pm >= 32) of = nullptr;
            const bool qk = pn <= 4, rot = qk && u.pm >= 32; const int half = wc >> 1, i0 = (wc & 1) * 16 + 4 * fq;
#pragma unroll
            for (int ai = 0; ai < 2; ++ai)
#pragma unroll
                for (int m = 0; m < 4; ++m) { const int row = rbase + ai * HALF + m * 16; bf16_t* rowp = dst + (size_t)row * ld + cl;
#pragma unroll
                    for (int bj = 0; bj < 2; ++bj) { f32x4 v0 = acc[ai][bj][m][0], v1 = acc[ai][bj][m][1];
                        if (rot) { const int t = (row - 8192) & 1023; const int p = half ? 16 + (t & 63) : (t >> 6); const float* rp = rope + (size_t)(p * 32 + i0) * 2;
                            const f32x4 r0 = *(const f32x4*)rp, r1 = *(const f32x4*)(rp + 4);
                            v0 = (f32x4){v0[0] * r0[0] - v0[1] * r0[1], v0[0] * r0[1] + v0[1] * r0[0], v0[2] * r0[2] - v0[3] * r0[3], v0[2] * r0[3] + v0[3] * r0[2]};
                            v1 = (f32x4){v1[0] * r1[0] - v1[1] * r1[1], v1[0] * r1[1] + v1[1] * r1[0], v1[2] * r1[2] - v1[3] * r1[3], v1[2] * r1[3] + v1[3] * r1[2]}; }
                        if (of) { float* op = of + (size_t)u.pm * 262144 + (size_t)(row - u.pm * BM) * 256 + bj * HALF;
                            if (pn == 4) { op += half * 64 + i0; *(f32x4*)op = (f32x4){v0[0], v0[2], v1[0], v1[2]}; *(f32x4*)(op + 32) = (f32x4){v0[1], v0[3], v1[1], v1[3]}; }
                            else { op += cl; *(f32x4*)op = v0; *(f32x4*)(op + 4) = v1; } }
                        if (act) {
#pragma unroll
                            for (int e = 0; e < 4; ++e) { v0[e] = siluf(v0[e]); v1[e] = siluf(v1[e]); } }
                        u32x4 w; w.x = cvt_pk_bf16(v0[0], v0[1]); w.y = cvt_pk_bf16(v0[2], v0[3]); w.z = cvt_pk_bf16(v1[0], v1[1]); w.w = cvt_pk_bf16(v1[2], v1[3]);
                        *(u32x4*)(rowp + bj * HALF) = w; } }
        }
    }
};
struct EpiRes {
    static constexpr bool PERM = false, AFTER_DRAIN = false;
    const float* xp; const float* xs; float* Y; const float* gate0;
    __device__ __forceinline__ void operator()(const f32x4 (&acc)[2][2][4][2], const Unit& u, int wr, int wc, int fr, int fq) const {
        const int cond = u.pm < 32 ? 0 : 1 + ((u.pm - 32) >> 2); const float* gate = gate0 + (size_t)cond * 12288;
        const int col0 = u.pn * BM + wc * 32 + 4 * fq; const int r0 = u.pm * BM + wr * 64 + fr;
        const float* __restrict__ xb = (u.pm < 32 ? xp + (size_t)r0 * 2048 : xs + (size_t)(r0 - 8192) * 2048) + col0; float* __restrict__ yb = Y + (size_t)r0 * 2048 + col0;
        f32x4 gv[2][2];
#pragma unroll
        for (int bj = 0; bj < 2; ++bj)
#pragma unroll
            for (int n = 0; n < 2; ++n) gv[bj][n] = *(const f32x4*)(gate + col0 + bj * HALF + n * 16);
        f32x4 xc[2][2], xn[2][2];
#pragma unroll
        for (int bj = 0; bj < 2; ++bj)
#pragma unroll
            for (int n = 0; n < 2; ++n) xc[bj][n] = *(const f32x4*)(xb + bj * HALF + n * 16);
#pragma unroll
        for (int it = 0; it < 8; ++it) { const int ai = it >> 2, m = it & 3; const size_t ro = (size_t)(ai * HALF + m * 16) * 2048;
            if (it < 7) { const int ai2 = (it + 1) >> 2, m2 = (it + 1) & 3; const size_t rn = (size_t)(ai2 * HALF + m2 * 16) * 2048;
#pragma unroll
                for (int bj = 0; bj < 2; ++bj)
#pragma unroll
                    for (int n = 0; n < 2; ++n) xn[bj][n] = *(const f32x4*)(xb + rn + bj * HALF + n * 16); }
#pragma unroll
            for (int bj = 0; bj < 2; ++bj)
#pragma unroll
                for (int n = 0; n < 2; ++n) { *(f32x4*)(yb + ro + bj * HALF + n * 16) = DN_ALPHA * xc[bj][n] + gv[bj][n] * acc[ai][bj][m][n]; xc[bj][n] = xn[bj][n]; } }
    }
};
struct EpiDown {
    static constexpr bool PERM = true, AFTER_DRAIN = false;
    bf16_t* SL; const float* gate0;
    __device__ __forceinline__ void operator()(const f32x4 (&acc)[2][2][4][2], const Unit& u, int wr, int wc, int fr, int fq) const {
        const int cond = u.pm < 32 ? 0 : 1 + ((u.pm - 32) >> 2); const float* gate = gate0 + (size_t)cond * 12288;
        const int col0 = u.pn * BM + wc * 32 + 8 * fq; const int r0 = u.pm * BM + wr * 64 + fr;
        f32x4 gv[2][2];
#pragma unroll
        for (int bj = 0; bj < 2; ++bj)
#pragma unroll
            for (int n = 0; n < 2; ++n) gv[bj][n] = *(const f32x4*)(gate + col0 + bj * HALF + n * 4);
        bf16_t* sl = SL + (size_t)u.ks * MT * 2048;
#pragma unroll
        for (int ai = 0; ai < 2; ++ai)
#pragma unroll
            for (int m = 0; m < 4; ++m) { bf16_t* sr = sl + (size_t)(r0 + ai * HALF + m * 16) * 2048 + col0;
#pragma unroll
                for (int bj = 0; bj < 2; ++bj) { const f32x4 v0 = gv[bj][0] * acc[ai][bj][m][0], v1 = gv[bj][1] * acc[ai][bj][m][1];
                    u32x4 w; w.x = cvt_pk_bf16(v0[0], v0[1]); w.y = cvt_pk_bf16(v0[2], v0[3]); w.z = cvt_pk_bf16(v1[0], v1[1]); w.w = cvt_pk_bf16(v1[2], v1[3]);
                    *(u32x4*)(sr + bj * HALF) = w; } }
    }
};
struct EpiUp {
    static constexpr bool PERM = true, AFTER_DRAIN = false;
    bf16_t* O;
    __device__ __forceinline__ void operator()(const f32x4 (&acc)[2][2][4][2], const Unit& u, int wr, int wc, int fr, int fq) const {
        const int row0 = u.pm * BM + wr * 64 + fr, col0 = (u.pn & 7) * BM + wc * 32 + 8 * fq;
        bf16_t* Ob = O + (size_t)(u.pn >> 3) * MT * 2048;
#pragma unroll
        for (int ai = 0; ai < 2; ++ai)
#pragma unroll
            for (int m = 0; m < 4; ++m) { bf16_t* rowp = Ob + (size_t)(row0 + ai * HALF + m * 16) * 2048 + col0;
#pragma unroll
                for (int bj = 0; bj < 2; ++bj) { f32x4 v0 = acc[ai][bj][m][0], v1 = acc[ai][bj][m][1];
#pragma unroll
                    for (int e = 0; e < 4; ++e) { const float a = fmaxf(v0[e], 0.f), b = fmaxf(v1[e], 0.f); v0[e] = a * a; v1[e] = b * b; }
                    u32x4 w; w.x = cvt_pk_bf16(v0[0], v0[1]); w.y = cvt_pk_bf16(v0[2], v0[3]); w.z = cvt_pk_bf16(v1[0], v1[1]); w.w = cvt_pk_bf16(v1[2], v1[3]);
                    *(u32x4*)(rowp + bj * HALF) = w; } }
    }
};
}

__device__ __forceinline__ void attn_task(const Frame& F, KArgs A, int l, int task, char* lds_gen) {
    const att::bf16* QB = (const att::bf16*)(F.ws + WS_QB); const att::bf16* KB = (const att::bf16*)(F.ws + WS_KB); const att::bf16* VB = (const att::bf16*)(F.ws + WS_VB);
    att::bf16* ATT = (att::bf16*)(F.ws + WS_ATT);
    const bool lat = task < 64;
    int h, row0, q0, kstart, nloc, sb = 0;
    if (lat) { sb = task >> 5; h = (task >> 2) & 7; const int qb = task & 3; row0 = NPR + sb * 1024; q0 = qb * 256;
        kstart = q0 - 128 < 0 ? 0 : q0 - 128; const int kend = q0 + 384 > 1024 ? 1024 : q0 + 384; nloc = (kend - kstart) >> 6; }
    else { const int t2 = task - 64; h = t2 & 7; row0 = (t2 >> 3) * 256; q0 = 0; kstart = 0; nloc = 4; }
    const int g = h >> 2;
    const size_t coff = (size_t)((sb * 4 + l) * 512) * 256 + g * 128;
    const att::bf16* Kl = KB + (size_t)(row0 + kstart) * 256 + g * 128; const att::bf16* Vl = VB + (size_t)(row0 + kstart) * 256 + g * 128;
    const att::bf16* Kc = lat ? (const att::bf16*)(F.ws + WS_CKB) + coff : Kl; const att::bf16* Vc = lat ? (const att::bf16*)(F.ws + WS_CVB) + coff : Vl;
    const float sink = GIN(11)[l * 8 + h];
    att::attn_body(QB + (size_t)(row0 + q0) * 1024 + h * 128, Kl, Vl, Kc, Vc, lat ? nloc + 8 : 4, nloc, lat, kstart, q0, sink * 1.4426950408889634f,
                   ATT + (size_t)(row0 + q0) * 1024 + h * 128, lds_gen, F.tid);
}

__device__ __forceinline__ void hgrn_task(const Frame& F, KArgs A, int l, int u) {
    const bool samp = u < 32; const int v = samp ? u : u - 32; const int bidx = v >> 4, h = (v >> 1) & 7, dir = v & 1; const int T = samp ? 1024 : 256; const int row0 = samp ? NPR + bidx * 1024 : bidx * 256;
    const float* LB = (const float*)(F.ws + WS_LB); const size_t soff = ((size_t)((bidx * 4 + l) * 8 + h)) * 16384;
    hg::hgrn_body(F.lds, F.tid, F.wave, (const float*)(F.ws + (dir ? WS_ZB : WS_ZF)), (const hg::bf16*)(F.ws + WS_HQ), (const hg::bf16*)(F.ws + WS_HI),
                  (hg::bf16*)(F.ws + (dir ? WS_OB : WS_OF)), LB + (size_t)(dir * 4 + l) * 1024 + h * 128,
                  samp ? (dir ? GIN(5) : GIN(4)) + soff : nullptr, samp ? nullptr : F.out + (dir ? OUT_SB : OUT_SF) + soff, row0, T, h * 128, dir);
}

__device__ __forceinline__ void mix_phase(const Frame& F, KArgs A, int l) {
    const int gw = F.vcu * 8 + F.wave, NGW = F.G * 8; bf16* MIX = (bf16*)(F.ws + WS_MIX);
    const bf16* ATT = (const bf16*)(F.ws + WS_ATT); const bf16* OFp = (const bf16*)(F.ws + WS_OF); const bf16* OBp = (const bf16*)(F.ws + WS_OB); const bf16* HG = (const bf16*)(F.ws + WS_HG);
    const float* ag = GIN(12) + (size_t)l * 1024 + F.lane * 16; const float* hgn = GIN(14) + (size_t)l * 128 + (F.lane & 7) * 16;
#define UNPK8(W_, o) do { const v4u w_ = (W_); o[0] = (f32x4){bflo(w_.x), bfhi(w_.x), bflo(w_.y), bfhi(w_.y)}; o[1] = (f32x4){bflo(w_.z), bfhi(w_.z), bflo(w_.w), bfhi(w_.w)}; } while (0)
    for (int r = gw; r < MT; r += NGW) {
        const size_t ro = (size_t)r * 1024 + F.lane * 16;
        f32x4 a[4]; float ss = 0.f;
        { const v4u wA = *(const v4u*)(ATT + ro), wB = *(const v4u*)(ATT + ro + 8); UNPK8(wA, (a + 0)); UNPK8(wB, (a + 2)); }
#pragma unroll
        for (int j = 0; j < 4; ++j) ss += (a[j][0] * a[j][0] + a[j][1] * a[j][1]) + (a[j][2] * a[j][2] + a[j][3] * a[j][3]);
        const float rs = 1.f / sqrtf(wave_sum(ss) * (1.f / 1024.f) + RMS_EPS);
        v4u w0, w1;
        { const f32x4 g0 = *(const f32x4*)(ag), g1 = *(const f32x4*)(ag + 4), g2 = *(const f32x4*)(ag + 8), g3 = *(const f32x4*)(ag + 12);
          const f32x4 y0 = a[0] * rs * g0, y1 = a[1] * rs * g1, y2 = a[2] * rs * g2, y3 = a[3] * rs * g3;
          w0.x = pk2(y0[0], y0[1]); w0.y = pk2(y0[2], y0[3]); w0.z = pk2(y1[0], y1[1]); w0.w = pk2(y1[2], y1[3]);
          w1.x = pk2(y2[0], y2[1]); w1.y = pk2(y2[2], y2[3]); w1.z = pk2(y3[0], y3[1]); w1.w = pk2(y3[2], y3[3]); }
        *(v4u*)(MIX + (size_t)r * 2048 + F.lane * 16) = w0; *(v4u*)(MIX + (size_t)r * 2048 + F.lane * 16 + 8) = w1;
        float s2 = 0.f;
        { const v4u fA = *(const v4u*)(OFp + ro), fB = *(const v4u*)(OFp + ro + 8), bA = *(const v4u*)(OBp + ro), bB = *(const v4u*)(OBp + ro + 8);
          f32x4 t[4]; UNPK8(fA, (a + 0)); UNPK8(fB, (a + 2)); UNPK8(bA, (t + 0)); UNPK8(bB, (t + 2));
#pragma unroll
          for (int j = 0; j < 4; ++j) { a[j] += t[j]; s2 += (a[j][0] * a[j][0] + a[j][1] * a[j][1]) + (a[j][2] * a[j][2] + a[j][3] * a[j][3]); } }
        s2 += __shfl_xor(s2, 1); s2 += __shfl_xor(s2, 2); s2 += __shfl_xor(s2, 4);
        const float r2 = 1.f / sqrtf(s2 * (1.f / 128.f) + RMS_EPS);
        const v4u gA = *(const v4u*)(HG + ro), gB = *(const v4u*)(HG + ro + 8);
        { const f32x4 g0 = *(const f32x4*)(hgn), g1 = *(const f32x4*)(hgn + 4), g2 = *(const f32x4*)(hgn + 8), g3 = *(const f32x4*)(hgn + 12);
          f32x4 t[4]; UNPK8(gA, (t + 0)); UNPK8(gB, (t + 2));
          const f32x4 y0 = a[0] * r2 * g0 * t[0], y1 = a[1] * r2 * g1 * t[1], y2 = a[2] * r2 * g2 * t[2], y3 = a[3] * r2 * g3 * t[3];
          w0.x = pk2(y0[0], y0[1]); w0.y = pk2(y0[2], y0[3]); w0.z = pk2(y1[0], y1[1]); w0.w = pk2(y1[2], y1[3]);
          w1.x = pk2(y2[0], y2[1]); w1.y = pk2(y2[2], y2[3]); w1.z = pk2(y3[0], y3[1]); w1.w = pk2(y3[2], y3[3]); }
        *(v4u*)(MIX + (size_t)r * 2048 + 1024 + F.lane * 16) = w0; *(v4u*)(MIX + (size_t)r * 2048 + 1024 + F.lane * 16 + 8) = w1;
    }
#undef UNPK8
}

__global__ void __launch_bounds__(512, 2) fwd_kernel(Args A_byval) {
    KArgs A = (KArgs)__builtin_amdgcn_kernarg_segment_ptr();
    extern __shared__ __attribute__((aligned(16))) unsigned char lds_raw[];
    Frame F;
    F.lds = (LAS unsigned char*)lds_raw; F.ws = (unsigned char*)(GAS unsigned char*)A->ws; F.out = (float*)(GAS float*)A->out; F.ctl = (unsigned*)(F.ws + WS_CTL);
    F.tid = threadIdx.x; F.lane = F.tid & 63; F.wave = __builtin_amdgcn_readfirstlane(F.tid >> 6);
    F.G = gridDim.x; { const int bx = blockIdx.x; F.vcu = (F.G % 8 == 0) ? (bx % 8) * (F.G / 8) + bx / 8 : bx; }
    volatile LAS unsigned* MISC = (volatile LAS unsigned*)(F.lds + MISC_OFF);
    for (int u = F.tid; u < (LDS_BYTES - LDSCTL_OFF) / 4; u += 512) ((LAS unsigned*)(F.lds + LDSCTL_OFF))[u] = 0u;
    __syncthreads();
    (void)xcd_barrier_post(F.ctl + CW_BAR, MISC + 8);
#define PHASE_BEGIN() do { int t_o = threadIdx.x; asm volatile("" : "+v"(t_o)); F.tid = t_o; F.lane = t_o & 63; F.wave = __builtin_amdgcn_readfirstlane(t_o >> 6); } while (0)
#define GRID_BAR() do { unsigned char* w_ = F.ws; asm volatile("" : "+s"(w_)); XcdBarrier b_; b_.bar = (unsigned*)(w_ + WS_CTL) + CW_BAR; b_.x = xb_xcc_id(); b_.st = MISC + 8; xcd_barrier(b_); } while (0)
    unsigned char* ws = F.ws;
    using pg8::bf16_t;

    p0_prologue(F, A);
    GRID_BAR(); PHASE_BEGIN();
    modulate0_phase(F, A);
    GRID_BAR(); PHASE_BEGIN();

    for (int l = 0; l < 4; ++l) {
        { int t_o = threadIdx.x; asm volatile("" : "+v"(t_o)); F.tid = t_o; F.lane = t_o & 63; F.wave = __builtin_amdgcn_readfirstlane(t_o >> 6); asm volatile("" : "+s"(A)); ws = (unsigned char*)(GAS unsigned char*)A->ws; F.ws = ws; F.out = (float*)(GAS float*)A->out; F.ctl = (unsigned*)(ws + WS_CTL); }
        const float* MODS_L = (const float*)(ws + WS_MODS) + (size_t)l * 3 * 12288;
        { pg8::Gemm g{(const bf16_t*)(ws + WS_H), (const bf16_t*)(ws + WS_WIN) + (size_t)l * IN_DIM * DM, MT, IN_DIM, DM, DM, 0, 0}; pg8::InOrder S{F.G, (int)blockIdx.x};
          pg8::EpiIn E{(bf16_t*)(ws + WS_QB), (bf16_t*)(ws + WS_KB), (bf16_t*)(ws + WS_VB), (bf16_t*)(ws + WS_HQ), (bf16_t*)(ws + WS_HI), (bf16_t*)(ws + WS_HG),
                       (float*)(ws + WS_ZF), (float*)(ws + WS_ZB), F.out + OUT_CK + (size_t)l * 65536, F.out + OUT_CV + (size_t)l * 65536, (const float*)(ws + WS_ROPE)};
          pg8::gemm_phase<pg8::EpiIn, pg8::InOrder, true, true>(F.lds, g, S, E); }
        GRID_BAR(); PHASE_BEGIN();
        for (;;) {
            if (F.tid == 0) MISC[0] = atomicAdd(F.ctl + CW_Q + 64 * l, 1u);
            __syncthreads();
            const int u = (int)MISC[0];
            __syncthreads();
            if (u >= 880) break;
            PHASE_BEGIN();
            if (u < 16) {
                pg8::Gemm g{(const bf16_t*)(ws + WS_H), (const bf16_t*)(ws + WS_WIN) + (size_t)l * IN_DIM * DM, MT, IN_DIM, DM, DM, 0, 0}; pg8::OneUnit S1{36 + (u >> 2), 22 + (u & 3)};
                pg8::EpiIn E{(bf16_t*)(ws + WS_QB), (bf16_t*)(ws + WS_KB), (bf16_t*)(ws + WS_VB), (bf16_t*)(ws + WS_HQ), (bf16_t*)(ws + WS_HI), (bf16_t*)(ws + WS_HG),
                             (float*)(ws + WS_ZF), (float*)(ws + WS_ZB), F.out + OUT_CK + (size_t)l * 65536, F.out + OUT_CV + (size_t)l * 65536, (const float*)(ws + WS_ROPE)};
                pg8::gemm_phase<pg8::EpiIn, pg8::OneUnit, true, true>(F.lds, g, S1, E);
            }
            else if (u < 48) hgrn_task(F, A, l, u - 16); else if (u >= 112 && u < 624) hgrn_task(F, A, l, u - 80);
            else if (u >= 48 && u < 112) attn_task(F, A, l, u - 48, (char*)lds_raw); else if (u >= 624) attn_task(F, A, l, u - 560, (char*)lds_raw);
        }
        GRID_BAR(); PHASE_BEGIN();
        mix_phase(F, A, l);
        GRID_BAR(); PHASE_BEGIN();
        { pg8::Gemm g{(const bf16_t*)(ws + WS_MIX), (const bf16_t*)(ws + WS_WO) + (size_t)l * DM * DM, MT, DM, DM, DM, 0, 0};
          const float* xp = l == 0 ? GIN(0) : (const float*)(ws + WS_X); const float* xs = l == 0 ? GIN(1) : (const float*)(ws + WS_X) + (size_t)NPR * DM;
          pg8::EpiRes E{xp, xs, (float*)(ws + WS_Y), MODS_L + 4096};
          { pg8::StaticOrder S; S.init(NPR, DM, F.G, (int)blockIdx.x); pg8::gemm_phase<pg8::EpiRes, pg8::StaticOrder, true, true>(F.lds, g, S, E); }
          GRID_BAR(); PHASE_BEGIN();
          if (F.G >= 128) {
              if (blockIdx.x < 64) { pg8::OneUnit S1{32 + ((int)blockIdx.x >> 3), (int)blockIdx.x & 7}; pg8::gemm_phase<pg8::EpiRes, pg8::OneUnit, true, true>(F.lds, g, S1, E); }
              else ln_phase(F, A, l, 0, 0, NPR, ((int)blockIdx.x - 64) * 8 + F.wave, (F.G - 64) * 8);
          } else {
              for (int uu = (int)blockIdx.x; uu < 64; uu += F.G) { pg8::OneUnit S1{32 + (uu >> 3), uu & 7}; pg8::gemm_phase<pg8::EpiRes, pg8::OneUnit, true, true>(F.lds, g, S1, E); }
              ln_phase(F, A, l, 0, 0, NPR, F.vcu * 8 + F.wave, F.G * 8);
          }
        }
        GRID_BAR(); PHASE_BEGIN();
        ln_phase(F, A, l, 0, NPR, MT, F.vcu * 8 + F.wave, F.G * 8);
        GRID_BAR(); PHASE_BEGIN();
        { pg8::Gemm g{(const bf16_t*)(ws + WS_H), (const bf16_t*)(ws + WS_WUP) + (size_t)l * DFF * DM, MT, DFF, DM, DM, 0, 0}; pg8::StaticOrder S; S.init(MT, DFF, F.G, (int)blockIdx.x);
          pg8::EpiUp E{(bf16_t*)(ws + WS_ACT)};
          pg8::gemm_phase<pg8::EpiUp, pg8::StaticOrder, true, true>(F.lds, g, S, E); }
        GRID_BAR(); PHASE_BEGIN();
        { pg8::Gemm g{(const bf16_t*)(ws + WS_ACT), (const bf16_t*)(ws + WS_WDN) + (size_t)l * DM * DFF, MT, DM, 2048, 2048, (size_t)MT * 2048 * 2, (size_t)2048 * 2048 * 2}; pg8::SplitOrder S; S.init(MT, 8192, F.G, (int)blockIdx.x);
          pg8::EpiDown E{(bf16_t*)(ws + WS_SL), MODS_L + 10240};
          pg8::gemm_phase<pg8::EpiDown, pg8::SplitOrder, true, true>(F.lds, g, S, E); }
        GRID_BAR(); PHASE_BEGIN();
        ln_phase(F, A, l, 1, 0, MT, F.vcu * 8 + F.wave, F.G * 8);
        GRID_BAR(); PHASE_BEGIN();
    }
}

extern "C" void kernel_launch(void* const* d_in, const int* in_sizes, int n_in, void* d_out, int out_size, void* d_ws, size_t ws_size, hipStream_t stream) {
    static int grid = 0;
    if (grid == 0) {
        if (n_in != 20 || ws_size < WS_END) { fprintf(stderr, "kernel_launch: unexpected n_in %d / ws %zu\n", n_in, ws_size); grid = -1; return; }
        int dev = 0, cus = 0, per_cu = 0;
        if (hipGetDevice(&dev) != hipSuccess || hipDeviceGetAttribute(&cus, hipDeviceAttributeMultiprocessorCount, dev) != hipSuccess) { grid = -1; return; }
        if (hipFuncSetAttribute((const void*)fwd_kernel, hipFuncAttributeMaxDynamicSharedMemorySize, LDS_BYTES) != hipSuccess) { fprintf(stderr, "kernel_launch: hipFuncSetAttribute failed\n"); grid = -1; return; }
        if (hipOccupancyMaxActiveBlocksPerMultiprocessor(&per_cu, (const void*)fwd_kernel, 512, LDS_BYTES) != hipSuccess || per_cu < 1) fprintf(stderr, "kernel_launch: occupancy query says %d\n", per_cu);
        (void)hipGetLastError();
        grid = cus;
    }
    if (grid < 0) return;
    if (hipMemsetAsync((char*)d_ws + WS_CTL, 0, CTL_ZERO_BYTES, stream) != hipSuccess) return;
    Args a{};
    for (int i = 0; i < 20; ++i) a.in[i] = (const float*)d_in[i];
    a.out = (float*)d_out; a.ws = (unsigned char*)d_ws;
    hipLaunchKernelGGL(fwd_kernel, dim3(grid), dim3(512), LDS_BYTES, stream, a);
}
```

```cpp
#include <hip/hip_runtime.h>
#include <cstdio>
#include <cstdint>
namespace pg8 {
#define PG8_LAS __attribute__((address_space(3)))
typedef unsigned short bf16_t;
typedef short bf16x8 __attribute__((ext_vector_type(8)));
typedef float f32x4 __attribute__((ext_vector_type(4)));
typedef unsigned u32x4 __attribute__((ext_vector_type(4)));
constexpr int BM = 256, BK = 64, HALF = 128, HTB = HALF * BK * 2  , STAGE_BYTES = 8 * HTB, NXCD = 8, WGM = 8;

__host__ __device__ __forceinline__ int lds_byte(int r, int c) { const int st = (r >> 4) * 2 + (c >> 5), rr = r & 15, cc = c & 31, ob = rr * 64 + cc * 2; return st * 1024 + (ob ^ (((ob >> 9) & 1) << 5)); }
__host__ __device__ __forceinline__ void stage_rc(int b, int& R, int& C) { const int st = b / 1024, sb = b % 1024, swz = sb ^ (((sb >> 9) & 1) << 5); R = (st >> 1) * 16 + swz / 64; C = (st & 1) * 32 + (swz % 64) / 2; }
__host__ __device__ __forceinline__ int perm32(int rho) { const int n = rho >> 4, i = rho & 15; return 8 * (i >> 2) + 4 * n + (i & 3); }

struct Unit { int pm, pn, ks; };
struct Gemm { const bf16_t* A; const bf16_t* Bt; int M, N, K, ld; size_t ksA, ksB; };

struct StaticOrder {
    int nM, nN, nwg, G, c;
    __host__ __device__ void init(int M, int N, int G_, int c_) { nM = M / BM; nN = N / BM; nwg = nM * nN; G = G_; c = c_; }
    __host__ __device__ bool next(int i, Unit& u) const {
        const long L = (long)i * G + c; if (L >= nwg) return false;
        int wgid = (int)L; { const int q = nwg / NXCD, r = nwg % NXCD, xcd = wgid % NXCD, off = wgid / NXCD; wgid = (xcd < r ? xcd * (q + 1) : r * (q + 1) + (xcd - r) * q) + off; }
        const int nig = WGM * nN, gid = wgid / nig, fm = gid * WGM, gsz = (nM - fm) < WGM ? (nM - fm) : WGM;
        u.pm = fm + ((wgid % nig) % gsz); u.pn = (wgid % nig) / gsz; u.ks = 0; return true;
    }
    __device__ __forceinline__ void a_ready(const Unit&) const {}
    __device__ __forceinline__ void done(const Unit&) const {}
};

__device__ __forceinline__ unsigned cvt_pk_bf16(float lo, float hi) { unsigned r; asm volatile("v_cvt_pk_bf16_f32 %0, %1, %2" : "=v"(r) : "v"(lo), "v"(hi)); return r; }
template <class Epi, class Sched, bool ALIGN_EPI = false, bool SP2 = false>
__device__ __forceinline__ void gemm_phase(PG8_LAS unsigned char* lds, const Gemm g, const Sched& S, const Epi& E) {
    int tid_o = threadIdx.x; asm volatile("" : "+v"(tid_o));
    const int tid = tid_o, wid = __builtin_amdgcn_readfirstlane(tid >> 6), lane = tid & 63, wr = wid >> 2, wc = wid & 3, fr = lane & 15, fq = lane >> 4;
    const int K = g.K, nt = K / BK, LD = g.ld;
    unsigned voffA[2], voffB[2];
#pragma unroll
    for (int i = 0; i < 2; ++i) { int R, C; stage_rc(tid * 16 + i * 8192, R, C); const int Rb = Epi::PERM ? ((R & ~31) + perm32(R & 31)) : R;
        voffA[i] = (unsigned)(R * LD + C) * 2u; voffB[i] = (unsigned)(Rb * LD + C) * 2u; }
    const size_t kstep = (size_t)(BK * 2);
    const size_t hstep = (size_t)HALF * LD * 2;
    const size_t tstep = 2 * hstep;
    const unsigned ldsw = (unsigned)wid * 1024u;
    const int aoff = lds_byte(wr * 64 + fr, fq * 8), boff = lds_byte(wc * 32 + fr, fq * 8);
#define PG8_SA(b, h) (((b) * 2 + (h)) * HTB)
#define PG8_SB(b, h) ((4 + (b) * 2 + (h)) * HTB)
#define PG8_STAGE(bufoff, gbase, voff) do { _Pragma("unroll") for (int _i = 0; _i < 2; ++_i) \
        __builtin_amdgcn_global_load_lds((const unsigned*)((const char*)(gbase) + (voff)[_i]), (PG8_LAS unsigned*)(lds + (bufoff) + ldsw + _i * 8192), 16, 0, 0); } while (0)
#define PG8_LDA(dst, b, h) do { _Pragma("unroll") for (int m = 0; m < 4; ++m) _Pragma("unroll") for (int k = 0; k < 2; ++k) dst[m][k] = *(const PG8_LAS bf16x8*)(lds + PG8_SA(b, h) + aoff + m * 2048 + k * 1024); } while (0)
#define PG8_LDB(dst, b, h) do { _Pragma("unroll") for (int n = 0; n < 2; ++n) _Pragma("unroll") for (int k = 0; k < 2; ++k) dst[n][k] = *(const PG8_LAS bf16x8*)(lds + PG8_SB(b, h) + boff + n * 2048 + k * 1024); } while (0)
#define PG8_MMA(ai, bj, At, Bt) do { __builtin_amdgcn_s_setprio(1); _Pragma("unroll") for (int m = 0; m < 4; ++m) _Pragma("unroll") for (int n = 0; n < 2; ++n) _Pragma("unroll") for (int k = 0; k < 2; ++k) \
        acc[ai][bj][m][n] = __builtin_amdgcn_mfma_f32_16x16x32_bf16(Bt[n][k], At[m][k], acc[ai][bj][m][n], 0, 0, 0); __builtin_amdgcn_s_setprio(0); } while (0)
#define PG8_WAIT_V(n) asm volatile("s_waitcnt vmcnt(" #n ")" ::: "memory")
#define PG8_WAIT_L(n) asm volatile("s_waitcnt lgkmcnt(" #n ")" ::: "memory")
#define PG8_BAR __builtin_amdgcn_s_barrier()
#define PG8_SCHED __builtin_amdgcn_sched_barrier(0)
    Unit cur, nxt; int ui = 0;
    if (!S.next(0, cur)) return;
    f32x4 acc[2][2][4][2];
#pragma unroll
    for (int a = 0; a < 2; ++a)
#pragma unroll
        for (int b = 0; b < 2; ++b)
#pragma unroll
            for (int m = 0; m < 4; ++m)
#pragma unroll
                for (int n = 0; n < 2; ++n) acc[a][b][m][n] = (f32x4){0.f, 0.f, 0.f, 0.f};
    bf16x8 At[4][2], B0[2][2], B1[2][2];
        const char* cA = (const char*)g.A + (size_t)cur.pm * tstep + (size_t)cur.ks * g.ksA; const char* cB = (const char*)g.Bt + (size_t)cur.pn * tstep + (size_t)cur.ks * g.ksB;
    S.a_ready(cur);
    if constexpr (SP2) {
        PG8_STAGE(PG8_SB(0, 0), cB, voffB); PG8_STAGE(PG8_SB(0, 1), cB + hstep, voffB); PG8_STAGE(PG8_SA(0, 0), cA, voffA); PG8_STAGE(PG8_SA(0, 1), cA + hstep, voffA);
        if (wr == 1) PG8_BAR;
        PG8_WAIT_V(2); PG8_BAR;
        PG8_STAGE(PG8_SB(1, 0), cB + kstep, voffB); PG8_STAGE(PG8_SA(1, 0), cA + kstep, voffA); PG8_STAGE(PG8_SB(1, 1), cB + hstep + kstep, voffB);
        PG8_WAIT_V(6); PG8_BAR;
    } else {
        PG8_STAGE(PG8_SB(0, 0), cB, voffB); PG8_STAGE(PG8_SA(0, 0), cA, voffA); PG8_STAGE(PG8_SB(0, 1), cB + hstep, voffB); PG8_STAGE(PG8_SA(0, 1), cA + hstep, voffA);
        if (wr == 1) PG8_BAR;
        PG8_WAIT_V(4); PG8_BAR;
        PG8_STAGE(PG8_SB(1, 0), cB + kstep, voffB); PG8_STAGE(PG8_SA(1, 0), cA + kstep, voffA); PG8_STAGE(PG8_SB(1, 1), cB + hstep + kstep, voffB);
        PG8_WAIT_V(6); PG8_BAR;
    }
    for (;;) {
        const bool has_next = S.next(ui + 1, nxt);
        const char* nA = has_next ? (const char*)g.A + (size_t)nxt.pm * tstep + (size_t)nxt.ks * g.ksA : cA; const char* nB = has_next ? (const char*)g.Bt + (size_t)nxt.pn * tstep + (size_t)nxt.ks * g.ksB : cB;
        for (int t = 0; t < nt; t += 2) {
            const bool last = (t == nt - 2);
            const char* a1 = cA + (size_t)(t + 1) * kstep;
            const char* a2 = last ? nA : cA + (size_t)(t + 2) * kstep; const char* b2 = last ? nB : cB + (size_t)(t + 2) * kstep;
            const char* a3 = a2 + kstep; const char* b3 = b2 + kstep;
            if (last && has_next) S.a_ready(nxt);
            if constexpr (SP2) {
            PG8_LDB(B0, 0, 0); PG8_LDB(B1, 0, 1); PG8_SCHED; PG8_LDA(At, 0, 0); PG8_STAGE(PG8_SA(1, 1), a1 + hstep, voffA);
            PG8_WAIT_V(8); PG8_WAIT_L(0); PG8_BAR; PG8_MMA(0, 0, At, B0); PG8_MMA(0, 1, At, B1); PG8_BAR; PG8_SCHED;
            PG8_LDA(At, 0, 1); PG8_STAGE(PG8_SB(0, 0), b2, voffB); PG8_STAGE(PG8_SB(0, 1), b2 + hstep, voffB); PG8_STAGE(PG8_SA(0, 0), a2, voffA);
            PG8_WAIT_V(8); PG8_WAIT_L(0); PG8_BAR; PG8_MMA(1, 0, At, B0); PG8_MMA(1, 1, At, B1); PG8_BAR; PG8_SCHED;
            PG8_LDB(B0, 1, 0); PG8_LDB(B1, 1, 1); PG8_SCHED; PG8_LDA(At, 1, 0); PG8_STAGE(PG8_SA(0, 1), a2 + hstep, voffA);
            PG8_WAIT_V(8); PG8_WAIT_L(0); PG8_BAR; PG8_MMA(0, 0, At, B0); PG8_MMA(0, 1, At, B1); PG8_BAR; PG8_SCHED;
            PG8_LDA(At, 1, 1); PG8_STAGE(PG8_SB(1, 0), b3, voffB); PG8_STAGE(PG8_SB(1, 1), b3 + hstep, voffB); PG8_STAGE(PG8_SA(1, 0), a3, voffA);
            PG8_WAIT_V(8); PG8_WAIT_L(0); PG8_BAR; PG8_MMA(1, 0, At, B0); PG8_MMA(1, 1, At, B1); PG8_BAR; PG8_SCHED;
            } else {
            PG8_LDB(B0, 0, 0); PG8_SCHED; PG8_LDA(At, 0, 0); PG8_STAGE(PG8_SA(1, 1), a1 + hstep, voffA);
            PG8_WAIT_L(8); PG8_BAR; PG8_WAIT_L(0); PG8_MMA(0, 0, At, B0); PG8_BAR; PG8_SCHED;
            PG8_LDB(B1, 0, 1); PG8_STAGE(PG8_SB(0, 0), b2, voffB);
            PG8_BAR; PG8_WAIT_L(0); PG8_MMA(0, 1, At, B1); PG8_BAR;
            PG8_LDA(At, 0, 1); PG8_STAGE(PG8_SA(0, 0), a2, voffA);
            PG8_BAR; PG8_WAIT_L(0); PG8_MMA(1, 0, At, B0); PG8_BAR; PG8_SCHED;
            PG8_STAGE(PG8_SB(0, 1), b2 + hstep, voffB);
            PG8_WAIT_V(6); PG8_BAR; PG8_MMA(1, 1, At, B1); PG8_BAR;
            PG8_LDB(B0, 1, 0); PG8_SCHED; PG8_LDA(At, 1, 0); PG8_STAGE(PG8_SA(0, 1), a2 + hstep, voffA);
            PG8_WAIT_L(8); PG8_BAR; PG8_WAIT_L(0); PG8_MMA(0, 0, At, B0); PG8_BAR; PG8_SCHED;
            PG8_LDB(B1, 1, 1); PG8_STAGE(PG8_SB(1, 0), b3, voffB);
            PG8_BAR; PG8_WAIT_L(0); PG8_MMA(0, 1, At, B1); PG8_BAR;
            PG8_LDA(At, 1, 1); PG8_STAGE(PG8_SA(1, 0), a3, voffA);
            PG8_BAR; PG8_WAIT_L(0); PG8_MMA(1, 0, At, B0); PG8_BAR; PG8_SCHED;
            PG8_STAGE(PG8_SB(1, 1), b3 + hstep, voffB);
            PG8_WAIT_V(6); PG8_BAR; PG8_MMA(1, 1, At, B1); PG8_BAR;
            }
        }
        if constexpr (ALIGN_EPI) { if (wr == 0) PG8_BAR; }
        if constexpr (!Epi::AFTER_DRAIN) { E(acc, cur, wr, wc, fr, fq); S.done(cur); }
        if (!has_next) break;
#pragma unroll
        for (int a = 0; a < 2; ++a)
#pragma unroll
            for (int b = 0; b < 2; ++b)
#pragma unroll
                for (int m = 0; m < 4; ++m)
#pragma unroll
                    for (int n = 0; n < 2; ++n) acc[a][b][m][n] = (f32x4){0.f, 0.f, 0.f, 0.f};
        cur = nxt; cA = nA; cB = nB; ++ui;
        if constexpr (ALIGN_EPI) { if (wr == 1) PG8_BAR; }
    }
    PG8_WAIT_V(0);
    if constexpr (!ALIGN_EPI) { if (wr == 0) PG8_BAR; }
    PG8_BAR;
    if constexpr (Epi::AFTER_DRAIN) { E.fused(acc, cur, wr, wc, fr, fq, lds, wid, lane); S.done(cur); }
#undef PG8_SA
#undef PG8_SB
#undef PG8_STAGE
#undef PG8_LDA
#undef PG8_LDB
#undef PG8_MMA
#undef PG8_WAIT_V
#undef PG8_WAIT_L
#undef PG8_BAR
#undef PG8_SCHED
}
}

namespace att {
typedef unsigned short bf16;
using bf16x8 = __attribute__((ext_vector_type(8))) short;
using s16x4  = __attribute__((ext_vector_type(4))) short;
using f32x16 = __attribute__((ext_vector_type(16))) float;
using u32x4  = __attribute__((ext_vector_type(4))) unsigned;
constexpr int   D = 128, NW = 8, QBLK = 32, KVBLK = 64, LDQ = 1024, LDK = 256, LDO = 1024;
constexpr float SCALE = 0.088388347648318440f, THR = 8.f;
constexpr size_t SHM_V = KVBLK * D * 2, SHM_K = KVBLK * D * 2, SHM_ATTN = 2 * SHM_V + 2 * SHM_K + NW * 64 * 4;
#define KSWZ(row, colB) ((row) * 256 + ((colB) ^ (((row) & 7) << 4)))
#define SBAR() __builtin_amdgcn_sched_barrier(0)
__device__ __forceinline__ int crow(int r, int hi) { return (r & 3) + 8 * (r >> 2) + 4 * hi; }
__device__ __forceinline__ unsigned cvtpk(float lo, float hi) { unsigned r; asm volatile("v_cvt_pk_bf16_f32 %0, %1, %2" : "=v"(r) : "v"(lo), "v"(hi)); return r; }

__device__ __forceinline__ void partialSM(f32x16& p0, f32x16& p1, float& m_reg, float& mn, float& alpha) {
  constexpr float C = SCALE * 1.4426950408889634f;
  float pmax = p0[0];
#pragma unroll
  for (int r = 1; r < 16; ++r) pmax = fmaxf(pmax, p0[r]);
#pragma unroll
  for (int r = 0; r < 16; ++r) pmax = fmaxf(pmax, p1[r]);
  { auto rr = __builtin_amdgcn_permlane32_swap(__float_as_uint(pmax), __float_as_uint(pmax), false, false);
    pmax = fmaxf(__uint_as_float(rr[0]), __uint_as_float(rr[1])); }
  if (__builtin_expect(__all(pmax - m_reg <= THR / SCALE), 1)) { mn = m_reg; alpha = 1.f; }
  else { mn = fmaxf(m_reg, pmax); alpha = __builtin_amdgcn_exp2f((m_reg - mn) * C); m_reg = mn; }
  float mnC = -mn * C;
#pragma unroll
  for (int r = 0; r < 16; ++r) p0[r] = fmaf(p0[r], C, mnC);
#pragma unroll
  for (int r = 0; r < 16; ++r) p1[r] = fmaf(p1[r], C, mnC);
#pragma unroll
  for (int r = 0; r < 16; ++r) p0[r] = __builtin_amdgcn_exp2f(p0[r]);
}
__device__ __forceinline__ void finishSM(f32x16& p0, f32x16& p1, float alpha, float& l_reg, bf16x8& pa0, bf16x8& pa1, bf16x8& pa2, bf16x8& pa3) {
#pragma unroll
  for (int r = 0; r < 16; ++r) p1[r] = __builtin_amdgcn_exp2f(p1[r]);
  float ps = 0;
#pragma unroll
  for (int r = 0; r < 16; ++r) ps += p0[r];
#pragma unroll
  for (int r = 0; r < 16; ++r) ps += p1[r];
  { auto rr = __builtin_amdgcn_permlane32_swap(__float_as_uint(ps), __float_as_uint(ps), false, false);
    ps = __uint_as_float(rr[0]) + __uint_as_float(rr[1]); }
  l_reg = l_reg * alpha + ps;
#define PK4(P, BASE, OUT) do { unsigned a0 = cvtpk(P[BASE + 0], P[BASE + 1]), a1 = cvtpk(P[BASE + 2], P[BASE + 3]);   \
    unsigned b0 = cvtpk(P[BASE + 4], P[BASE + 5]), b1 = cvtpk(P[BASE + 6], P[BASE + 7]);                              \
    auto r0 = __builtin_amdgcn_permlane32_swap(a0, b0, false, false); auto r1 = __builtin_amdgcn_permlane32_swap(a1, b1, false, false); \
    u32x4 w = {r0[0], r1[0], r0[1], r1[1]}; OUT = *reinterpret_cast<bf16x8*>(&w); } while (0)
  PK4(p0, 0, pa0); PK4(p0, 8, pa1); PK4(p1, 0, pa2); PK4(p1, 8, pa3);
#undef PK4
}
__device__ __forceinline__ void qkt(f32x16& p0, f32x16& p1, const bf16* Ks, const bf16x8* qr, int r32, int hi, bool domask, int mbase) {
  if (domask) {
#pragma unroll
    for (int r = 0; r < 16; ++r) { const int c = (r & 3) + 8 * (r >> 2);
      p0[r] = ((unsigned)(mbase + c + 128) <= 256u) ? 0.f : -INFINITY; p1[r] = ((unsigned)(mbase + c + 32 + 128) <= 256u) ? 0.f : -INFINITY; }
  } else { p0 = f32x16{}; p1 = f32x16{}; }
#pragma unroll
  for (int d0 = 0; d0 < 8; ++d0) { int cb = (d0 * 16 + hi * 8) * 2;
    bf16x8 b0 = *reinterpret_cast<const bf16x8*>((const char*)Ks + KSWZ(r32, cb));
    bf16x8 b1 = *reinterpret_cast<const bf16x8*>((const char*)Ks + KSWZ(32 + r32, cb));
    p0 = __builtin_amdgcn_mfma_f32_32x32x16_bf16(b0, qr[d0], p0, 0, 0, 0);
    p1 = __builtin_amdgcn_mfma_f32_32x32x16_bf16(b1, qr[d0], p1, 0, 0, 0); }
}
__device__ __forceinline__ int v_st(int k, int c) { const int kk = (k & ~0xC) | ((k & 4) << 1) | ((k & 8) >> 1); return ((kk >> 3) * 4 + (c >> 5)) * 512 + ((kk & 7) * 32 + (c & 31)) * 2; }
__device__ __forceinline__ int v_rd_base(int lane) { return ((lane & 3) << 3) | (((lane >> 2) & 3) << 6) | (((lane >> 4) & 1) << 5) | (((lane >> 5) & 1) << 8); }
constexpr int v_rd_off(int d0, int ks, int half) { return d0 * 512 + ks * 4096 + half * 2048; }
template <int OFF> __device__ __forceinline__ s16x4 tr_read(int vb) {
  s16x4 r; asm volatile("ds_read_b64_tr_b16 %0, %1 offset:%2" : "=&v"(r) : "v"(vb), "i"(OFF) : "memory"); return r;
}
template <int D0> __device__ __forceinline__ void pv_one(f32x16& od, int vb, bf16x8 pa0, bf16x8 pa1, bf16x8 pa2, bf16x8 pa3) {
  const s16x4 l0 = tr_read<v_rd_off(D0, 0, 0)>(vb), h0 = tr_read<v_rd_off(D0, 0, 1)>(vb), l1 = tr_read<v_rd_off(D0, 1, 0)>(vb), h1 = tr_read<v_rd_off(D0, 1, 1)>(vb);
  const s16x4 l2 = tr_read<v_rd_off(D0, 2, 0)>(vb), h2 = tr_read<v_rd_off(D0, 2, 1)>(vb), l3 = tr_read<v_rd_off(D0, 3, 0)>(vb), h3 = tr_read<v_rd_off(D0, 3, 1)>(vb);
  asm volatile("s_waitcnt lgkmcnt(0)" ::: "memory"); SBAR();
#define PK(L, H) (bf16x8){L[0], L[1], L[2], L[3], H[0], H[1], H[2], H[3]}
  od = __builtin_amdgcn_mfma_f32_32x32x16_bf16(pa0, PK(l0, h0), od, 0, 0, 0);
  od = __builtin_amdgcn_mfma_f32_32x32x16_bf16(pa1, PK(l1, h1), od, 0, 0, 0);
  od = __builtin_amdgcn_mfma_f32_32x32x16_bf16(pa2, PK(l2, h2), od, 0, 0, 0);
  od = __builtin_amdgcn_mfma_f32_32x32x16_bf16(pa3, PK(l3, h3), od, 0, 0, 0);
#undef PK
}
__device__ __forceinline__ void pv_d0(f32x16* o, int vb, bf16x8 pa0, bf16x8 pa1, bf16x8 pa2, bf16x8 pa3) {
  pv_one<0>(o[0], vb, pa0, pa1, pa2, pa3); pv_one<1>(o[1], vb, pa0, pa1, pa2, pa3); pv_one<2>(o[2], vb, pa0, pa1, pa2, pa3); pv_one<3>(o[3], vb, pa0, pa1, pa2, pa3);
}

__device__ __forceinline__ void attn_body(const bf16* __restrict__ Qb, const bf16* __restrict__ Kl, const bf16* __restrict__ Vl, const bf16* __restrict__ Kc, const bf16* __restrict__ Vc,
                                          int NT, int nloc, bool masked, int kp0, int q0, float sink_l2, bf16* __restrict__ Ob, char* lds, int tid) {
  const int wid = tid >> 6, lane = tid & 63, r32 = lane & 31, hi = lane >> 5;
  bf16* V_lds = (bf16*)lds; bf16* K_lds = (bf16*)(lds + 2 * SHM_V);
  float* wsl = (float*)(lds + 2 * SHM_V + 2 * SHM_K) + wid * 64; float* li_l = wsl; float* al_l = wsl + 32;
  float m_reg = -1e30f, l_reg = 0; f32x16 o[4] = {}; bf16x8 qr[8];
  const bf16* Qw = Qb + (long)(wid * QBLK + r32) * LDQ + hi * 8;
#pragma unroll
  for (int d0 = 0; d0 < 8; ++d0) qr[d0] = *reinterpret_cast<const bf16x8*>(Qw + d0 * 16);
  const int sr = tid >> 4, sc = (tid & 15) * 8, vst0 = v_st(sr, sc), vst1 = v_st(32 + sr, sc);
  const int vb0 = (int)(uintptr_t)V_lds + v_rd_base(lane);
  const int mb0 = kp0 - (q0 + wid * QBLK + r32) + 4 * hi;
  struct { bf16x8 vs0, vs1, ks0, ks1; } sr_[2];
#define TILEK(j) ((j) < nloc ? Kl + (long)(j) * (KVBLK * LDK) : Kc + (long)((j) - nloc) * (KVBLK * LDK))
#define TILEV(j) ((j) < nloc ? Vl + (long)(j) * (KVBLK * LDK) : Vc + (long)((j) - nloc) * (KVBLK * LDK))
#define SLOAD(i, j) do { const bf16* kt_ = TILEK(j); const bf16* vt_ = TILEV(j); \
    sr_[i].vs0 = *reinterpret_cast<const bf16x8*>(&vt_[(long)(sr) * LDK + sc]); sr_[i].vs1 = *reinterpret_cast<const bf16x8*>(&vt_[(long)(32 + sr) * LDK + sc]); \
    sr_[i].ks0 = *reinterpret_cast<const bf16x8*>(&kt_[(long)(sr) * LDK + sc]); sr_[i].ks1 = *reinterpret_cast<const bf16x8*>(&kt_[(long)(32 + sr) * LDK + sc]); } while (0)
#define SWRITE(b, i) do { *(bf16x8*)((char*)V_lds + (b) * SHM_V + vst0) = sr_[i].vs0;          \
    *(bf16x8*)((char*)V_lds + (b) * SHM_V + vst1) = sr_[i].vs1; int kc = sc * 2;               \
    *(bf16x8*)((char*)K_lds + (b) * SHM_K + KSWZ(sr, kc)) = sr_[i].ks0;                       \
    *(bf16x8*)((char*)K_lds + (b) * SHM_K + KSWZ(32 + sr, kc)) = sr_[i].ks1; } while (0)
#define SWAIT() asm volatile("s_waitcnt vmcnt(4)" ::: "memory")
#define RESC(a) do { if (__any((a) < 1.f)) { if (hi == 0) al_l[r32] = (a); asm volatile("s_waitcnt lgkmcnt(0)" ::: "memory"); \
    _Pragma("unroll") for (int d = 0; d < 4; ++d) _Pragma("unroll") for (int r = 0; r < 16; ++r) o[d][r] *= al_l[crow(r, hi)]; } } while (0)
#define QKT(P0, P1, KS, j) qkt(P0, P1, KS, qr, r32, hi, masked && (j) < nloc, mb0 + 64 * (j))
  f32x16 pA0, pA1, pB0, pB1; float mnA, mnB, alA, alB; bf16x8 pa0, pa1, pa2, pa3;
  constexpr int SE = 0, SO = 1;
  SLOAD(SE, 0); asm volatile("s_waitcnt vmcnt(0)" ::: "memory"); SWRITE(0, SE); __syncthreads();
  QKT(pA0, pA1, K_lds, 0); partialSM(pA0, pA1, m_reg, mnA, alA);
  SLOAD(SO, 1); if (2 < NT) SLOAD(SE, 2);
  SWAIT(); SWRITE(1, SO); __syncthreads();
  for (int j = 1; j + 1 < NT; j += 2) {
    SBAR(); QKT(pB0, pB1, (bf16*)((char*)K_lds + SHM_K), j);
    finishSM(pA0, pA1, alA, l_reg, pa0, pa1, pa2, pa3); SBAR();
    SLOAD(SO, (j + 2 < NT ? j + 2 : NT - 1)); SBAR();
    pv_d0(o, vb0, pa0, pa1, pa2, pa3); partialSM(pB0, pB1, m_reg, mnB, alB);
    __syncthreads(); SWAIT(); SWRITE(0, SE);
    RESC(alB); __syncthreads();
    SBAR(); QKT(pA0, pA1, K_lds, j + 1);
    finishSM(pB0, pB1, alB, l_reg, pa0, pa1, pa2, pa3); SBAR();
    if (j + 3 < NT) SLOAD(SE, j + 3); SBAR();
    pv_d0(o, vb0 + (int)SHM_V, pa0, pa1, pa2, pa3); partialSM(pA0, pA1, m_reg, mnA, alA);
    __syncthreads(); SWAIT(); SWRITE(1, SO);
    RESC(alA); __syncthreads();
  }
  SBAR(); QKT(pB0, pB1, (bf16*)((char*)K_lds + SHM_K), NT - 1);
  finishSM(pA0, pA1, alA, l_reg, pa0, pa1, pa2, pa3); SBAR();
  pv_d0(o, vb0, pa0, pa1, pa2, pa3); partialSM(pB0, pB1, m_reg, mnB, alB);
  __syncthreads(); RESC(alB);
  finishSM(pB0, pB1, alB, l_reg, pa0, pa1, pa2, pa3); SBAR();
  pv_d0(o, vb0 + (int)SHM_V, pa0, pa1, pa2, pa3);
  l_reg += __builtin_amdgcn_exp2f(sink_l2 - m_reg * (SCALE * 1.4426950408889634f));
  if (hi == 0) li_l[r32] = l_reg; asm volatile("s_waitcnt lgkmcnt(0)" ::: "memory");
  float rli[16];
#pragma unroll
  for (int r = 0; r < 16; ++r) rli[r] = __builtin_amdgcn_rcpf(li_l[crow(r, hi)]);
  bf16* Ow = Ob + (long)(wid * QBLK) * LDO;
#pragma unroll
  for (int r = 0; r < 16; ++r) { int orow = crow(r, hi);
#pragma unroll
    for (int d0 = 0; d0 < 4; ++d0) { const float ov = o[d0][r] * rli[r]; Ow[(long)orow * LDO + d0 * 32 + r32] = (bf16)cvtpk(ov, ov); } }
  __syncthreads();
#undef TILEK
#undef TILEV
#undef SLOAD
#undef SWRITE
#undef SWAIT
#undef RESC
#undef QKT
}
#undef KSWZ
#undef SBAR
}

constexpr int DM = 2048, NPR = 8192, NSR = 2048, MT = 10240, IN_DIM = 6656, DFF = 8192;
constexpr float LN_EPS = 1e-5f, RMS_EPS = 1e-6f, DN_ALPHA = 1.681792830507429f, ATT_SCALE = 0.08838834764831845f;
constexpr size_t OUT_CK = 20971520, OUT_CV = 29360128, OUT_SF = 37748736, OUT_SB = 54525952;
constexpr size_t MiB = 1u << 20;
constexpr size_t WS_CTL = 0, CTL_ZERO_BYTES = 1 * MiB;
constexpr size_t WS_ROPE = 1 * MiB, WS_LB = 1 * MiB + 65536, WS_MODS = 2 * MiB;
constexpr size_t WS_WIN = 4 * MiB, WS_WO = 108 * MiB, WS_WUP = 140 * MiB, WS_WDN = 268 * MiB;
constexpr size_t WS_X = 396 * MiB, WS_Y = 476 * MiB, WS_H = 556 * MiB, WS_MIX = 596 * MiB, WS_ACT = 636 * MiB;
constexpr size_t WS_QB = 796 * MiB, WS_KB = 816 * MiB, WS_VB = 821 * MiB, WS_HQ = 826 * MiB, WS_HI = 846 * MiB, WS_HG = 866 * MiB;
constexpr size_t WS_ZF = 886 * MiB, WS_ZB = 926 * MiB, WS_OF = 966 * MiB, WS_OB = 1006 * MiB, WS_ATT = 1046 * MiB, WS_CKB = 1086 * MiB, WS_CVB = 1088 * MiB, WS_SL = 1090 * MiB, WS_END = 1250 * MiB;
constexpr int CW_BAR = 4096, CW_Q = 16384;
constexpr int RING_BYTES = 131072, LDS_BYTES = 163840, LDSCTL_OFF = LDS_BYTES - 512, MISC_OFF = LDSCTL_OFF + 320;

#define GAS __attribute__((address_space(1)))
#define LAS __attribute__((address_space(3)))
typedef unsigned short bf16;
typedef unsigned v4u __attribute__((ext_vector_type(4)));
typedef unsigned v2u __attribute__((ext_vector_type(2)));
typedef float f32x4 __attribute__((ext_vector_type(4)));
typedef float f32x2 __attribute__((ext_vector_type(2)));
typedef GAS unsigned gu32;
#define LDS_WAIT() asm volatile("s_waitcnt lgkmcnt(0)" ::: "memory")
typedef float f32x2_t __attribute__((ext_vector_type(2))); typedef __bf16 bf16x2_t __attribute__((ext_vector_type(2)));
__device__ __forceinline__ unsigned pk2(float lo, float hi) { f32x2_t v = {lo, hi}; bf16x2_t b = __builtin_convertvector(v, bf16x2_t); return __builtin_bit_cast(unsigned, b); }
__device__ __forceinline__ unsigned f2bf(float f) { return pk2(f, f) & 0xffffu; }
__device__ __forceinline__ float bflo(unsigned w) { return __builtin_bit_cast(float, w << 16); }
__device__ __forceinline__ float bfhi(unsigned w) { return __builtin_bit_cast(float, w & 0xffff0000u); }
__device__ __forceinline__ float bf2f(bf16 b) { return __builtin_bit_cast(float, ((unsigned)b) << 16); }
__device__ __forceinline__ float siluf(float x) { return x * __builtin_amdgcn_rcpf(1.f + __expf(-x)); }


namespace hg {
typedef unsigned short bf16;
using bf16x8 = __attribute__((ext_vector_type(8))) short;
using bf16x4 = __attribute__((ext_vector_type(4))) short;
using f32x16 = __attribute__((ext_vector_type(16))) float;
constexpr int QS = 136, TS = 40;
constexpr int OFF_QT = 0, OFF_KT = 8704, OFF_KTT = 17408, OFF_EMID = 27648, OFF_ELM = 28160, OFF_VT = 28672, VT_BYTES = 2560, BUF_BYTES = 38912;
constexpr int HG_LDS_BYTES = 4 * BUF_BYTES;
__device__ __forceinline__ int crow(int r, int hi) { return (r & 3) + 8 * (r >> 2) + 4 * hi; }
__device__ __forceinline__ unsigned cvtpk(float lo, float hi) { return ::pk2(lo, hi); }
__device__ __forceinline__ unsigned f2bfc(float f) { unsigned u = __builtin_bit_cast(unsigned, f); return (u + 0x7fffu + ((u >> 16) & 1u)) >> 16; }
__device__ __forceinline__ unsigned pk2c(float lo, float hi) { return ::pk2(lo, hi); }
__device__ __forceinline__ bf16x8 pack8(const f32x16& x, int b) {
  typedef unsigned u32x4 __attribute__((ext_vector_type(4)));
  u32x4 w = {cvtpk(x[b + 0], x[b + 1]), cvtpk(x[b + 2], x[b + 3]), cvtpk(x[b + 4], x[b + 5]), cvtpk(x[b + 6], x[b + 7])}; return __builtin_bit_cast(bf16x8, w);
}
__device__ __forceinline__ bf16x8 cat4(bf16x4 a, bf16x4 b) { return (bf16x8){a[0], a[1], a[2], a[3], b[0], b[1], b[2], b[3]}; }

__device__ __forceinline__ void gates_to_lds(LAS unsigned char* buf, const float (&zr)[16], const bf16 (&qr)[16], bf16x8 va, bf16x8 vb, float lbv, float olb, int dkg, int half, int js, int r32, int hi) {
  LAS bf16* Qt = (LAS bf16*)(buf + OFF_QT); LAS bf16* Kt = (LAS bf16*)(buf + OFF_KT); LAS bf16* KtT = (LAS bf16*)(buf + OFF_KTT);
  LAS float* emid = (LAS float*)(buf + OFF_EMID); LAS float* elm = (LAS float*)(buf + OFF_ELM); LAS bf16* Vt = (LAS bf16*)(buf + OFF_VT + js * VT_BYTES);
  float fz[16], kz[16], qt[16], kt[16];
#pragma unroll
  for (int ii = 0; ii < 16; ++ii) { const float rr = __builtin_amdgcn_rcpf(1.f + __expf(-zr[ii]));
    fz[ii] = fmaf(olb, rr, lbv); kz[ii] = fmaf(-olb, rr, olb); qt[ii] = __builtin_bit_cast(float, ((unsigned)qr[ii]) << 16); }
  if (half) { float E = 1.f;
#pragma unroll
    for (int ii = 0; ii < 16; ++ii) { E = fmaxf(E * fz[ii], 1e-30f); qt[ii] *= E; kt[ii] = kz[ii] * __builtin_amdgcn_rcpf(E); }
    elm[dkg] = E;
  } else { float Dd = 1.f;
#pragma unroll
    for (int ii = 15; ii >= 0; --ii) { qt[ii] *= __builtin_amdgcn_rcpf(Dd); kt[ii] = kz[ii] * Dd; Dd = fmaxf(Dd * fz[ii], 1e-30f); }
    emid[dkg] = Dd;
  }
  unsigned kw[8];
#pragma unroll
  for (int m = 0; m < 8; ++m) { const unsigned qw = cvtpk(qt[2 * m], qt[2 * m + 1]); kw[m] = cvtpk(kt[2 * m], kt[2 * m + 1]); const int i0 = 16 * half + 2 * m;
    Qt[i0 * QS + dkg] = (bf16)qw; Qt[(i0 + 1) * QS + dkg] = (bf16)(qw >> 16); Kt[i0 * QS + dkg] = (bf16)kw[m]; Kt[(i0 + 1) * QS + dkg] = (bf16)(kw[m] >> 16); }
  typedef unsigned u32x4 __attribute__((ext_vector_type(4)));
  LAS u32x4* kd = (LAS u32x4*)(KtT + dkg * TS + 16 * half);
  kd[0] = (u32x4){kw[0], kw[1], kw[2], kw[3]}; kd[1] = (u32x4){kw[4], kw[5], kw[6], kw[7]};
#pragma unroll
  for (int e = 0; e < 8; ++e) { Vt[(16 * hi + e) * TS + r32] = (bf16)va[e]; Vt[(16 * hi + 8 + e) * TS + r32] = (bf16)vb[e]; }
}

__device__ __forceinline__ f32x16 chunk_mfma(LAS unsigned char* buf, f32x16 (&S)[4], int js, int r32, int hi) {
  const LAS bf16* Qt = (const LAS bf16*)(buf + OFF_QT); const LAS bf16* Kt = (const LAS bf16*)(buf + OFF_KT); const LAS bf16* KtT = (const LAS bf16*)(buf + OFF_KTT);
  const LAS float* emid = (const LAS float*)(buf + OFF_EMID); const LAS float* elm = (const LAS float*)(buf + OFF_ELM); const LAS bf16* Vt = (const LAS bf16*)(buf + OFF_VT + js * VT_BYTES);
  bf16x8 Sb[4][2];
#pragma unroll
  for (int Tt = 0; Tt < 4; ++Tt) {
#pragma unroll
    for (int qd = 0; qd < 4; ++qd) { const f32x4 em = *(const LAS f32x4*)(emid + 32 * Tt + 8 * qd + 4 * hi);
#pragma unroll
      for (int e = 0; e < 4; ++e) S[Tt][4 * qd + e] *= em[e]; }
    Sb[Tt][0] = pack8(S[Tt], 0); Sb[Tt][1] = pack8(S[Tt], 8); }
  f32x16 AT = {}, oT = {};
#pragma unroll
  for (int hb = 0; hb < 2; ++hb) { bf16x8 ka[4], qb[4], qp[2][2];
#pragma unroll
    for (int st = 0; st < 4; ++st) { ka[st] = *(const LAS bf16x8*)(Kt + r32 * QS + 16 * (4 * hb + st) + 8 * hi); qb[st] = *(const LAS bf16x8*)(Qt + r32 * QS + 16 * (4 * hb + st) + 8 * hi); }
#pragma unroll
    for (int t2 = 0; t2 < 2; ++t2)
#pragma unroll
      for (int s2 = 0; s2 < 2; ++s2) { const LAS bf16* qr = Qt + r32 * QS + 32 * (2 * hb + t2) + 16 * s2 + 4 * hi; qp[t2][s2] = cat4(*(const LAS bf16x4*)(qr), *(const LAS bf16x4*)(qr + 8)); }
#pragma unroll
    for (int j = 0; j < 4; ++j) { AT = __builtin_amdgcn_mfma_f32_32x32x16_bf16(ka[j], qb[j], AT, 0, 0, 0);
      oT = __builtin_amdgcn_mfma_f32_32x32x16_bf16(Sb[2 * hb + (j >> 1)][j & 1], qp[j >> 1][j & 1], oT, 0, 0, 0); } }
  { const bf16x8 v0 = *(const LAS bf16x8*)(Vt + r32 * TS + 8 * hi), v1 = *(const LAS bf16x8*)(Vt + r32 * TS + 16 + 8 * hi);
    bf16x8 kf[4][2];
#pragma unroll
    for (int Tt = 0; Tt < 4; ++Tt) { const LAS bf16* kr = KtT + (32 * Tt + r32) * TS + 8 * hi; kf[Tt][0] = *(const LAS bf16x8*)(kr); kf[Tt][1] = *(const LAS bf16x8*)(kr + 16); }
#pragma unroll
    for (int Tt = 0; Tt < 4; ++Tt) S[Tt] = __builtin_amdgcn_mfma_f32_32x32x16_bf16(kf[Tt][0], v0, S[Tt], 0, 0, 0);
#pragma unroll
    for (int Tt = 0; Tt < 4; ++Tt) S[Tt] = __builtin_amdgcn_mfma_f32_32x32x16_bf16(kf[Tt][1], v1, S[Tt], 0, 0, 0); }
#pragma unroll
  for (int r = 0; r < 16; ++r) AT[r] = (crow(r, hi) <= r32) ? AT[r] : 0.f;
  { const bf16x8 Pb0 = pack8(AT, 0), Pb1 = pack8(AT, 8); const LAS bf16* vr = Vt + r32 * TS + 4 * hi;
    const bf16x8 v0 = cat4(*(const LAS bf16x4*)(vr), *(const LAS bf16x4*)(vr + 8)), v1 = cat4(*(const LAS bf16x4*)(vr + 16), *(const LAS bf16x4*)(vr + 24));
    oT = __builtin_amdgcn_mfma_f32_32x32x16_bf16(v0, Pb0, oT, 0, 0, 0);
    oT = __builtin_amdgcn_mfma_f32_32x32x16_bf16(v1, Pb1, oT, 0, 0, 0); }
#pragma unroll
  for (int Tt = 0; Tt < 4; ++Tt)
#pragma unroll
    for (int qd = 0; qd < 4; ++qd) { const f32x4 el = *(const LAS f32x4*)(elm + 32 * Tt + 8 * qd + 4 * hi);
#pragma unroll
      for (int e = 0; e < 4; ++e) S[Tt][4 * qd + e] *= el[e]; }
  return oT;
}

__device__ __forceinline__ void hgrn_body(LAS unsigned char* base, int tid, int wave, const float* __restrict__ Z, const bf16* __restrict__ HQ, const bf16* __restrict__ HI,
                                          bf16* __restrict__ O, const float* __restrict__ lb, const float* __restrict__ s_in, float* __restrict__ s_out, int row0, int T, int hcol, int dir) {
  const int lane = tid & 63, role = wave >> 2, js = wave & 3, r32 = lane & 31, hi = lane >> 5;
  const int nch = T >> 5;
#define HG_BAR() asm volatile("s_waitcnt lgkmcnt(0)\n\ts_barrier" ::: "memory")
  if (role) {
    const int lt = tid & 255, dkg = lt & 127, half = (wave >> 1) & 1;
    const float lbv = lb[dkg], olb = 1.f - lbv;
    float zr[16]; bf16 qr[16]; bf16x8 va, vb;
#define HG_LOAD(nn) do { _Pragma("unroll") for (int ii = 0; ii < 16; ++ii) { const int i_ = 32 * (nn) + 16 * half + ii, t_ = dir ? T - 1 - i_ : i_; const size_t off_ = (size_t)(row0 + t_) * 1024 + hcol + dkg; \
      zr[ii] = Z[off_]; qr[ii] = HQ[off_]; } \
    { const int i_ = 32 * (nn) + r32, t_ = dir ? T - 1 - i_ : i_; const bf16* src_ = HI + (size_t)(row0 + t_) * 1024 + hcol + 32 * js + 16 * hi; va = *(const bf16x8*)src_; vb = *(const bf16x8*)(src_ + 8); } } while (0)
    HG_LOAD(0);
    gates_to_lds(base, zr, qr, va, vb, lbv, olb, dkg, half, js, r32, hi);
    HG_LOAD(nch > 1 ? 1 : 0);
    HG_BAR();
    for (int n = 0; n < nch; ++n) {
      if (n + 1 < nch) gates_to_lds(base + ((n + 1) & 1) * BUF_BYTES, zr, qr, va, vb, lbv, olb, dkg, half, js, r32, hi);
      { const int nn = n + 2 < nch ? n + 2 : nch - 1; HG_LOAD(nn); }
      HG_BAR();
    }
#undef HG_LOAD
  } else {
    f32x16 S[4];
#pragma unroll
    for (int Tt = 0; Tt < 4; ++Tt)
#pragma unroll
      for (int r = 0; r < 16; ++r) S[Tt][r] = s_in ? s_in[(size_t)(32 * Tt + crow(r, hi)) * 128 + 32 * js + r32] : 0.f;
    HG_BAR();
    for (int n = 0; n < nch; ++n) {
      const f32x16 oT = chunk_mfma(base + (n & 1) * BUF_BYTES, S, js, r32, hi);
      { const int i = 32 * n + r32, t = dir ? T - 1 - i : i; bf16* op = O + (size_t)(row0 + t) * 1024 + hcol + 32 * js + 4 * hi; typedef unsigned u32x2_t __attribute__((ext_vector_type(2)));
#pragma unroll
        for (int qd = 0; qd < 4; ++qd) { u32x2_t w; w.x = pk2c(oT[4 * qd], oT[4 * qd + 1]); w.y = pk2c(oT[4 * qd + 2], oT[4 * qd + 3]);     *(u32x2_t*)(op + 8 * qd) = w; } }
      HG_BAR();
    }
    if (s_out) {
#pragma unroll
      for (int Tt = 0; Tt < 4; ++Tt)
#pragma unroll
        for (int r = 0; r < 16; ++r) s_out[(size_t)(32 * Tt + crow(r, hi)) * 128 + 32 * js + r32] = S[Tt][r];
    }
  }
#undef HG_BAR
}
}
#define XB_TMO      128
#define XB_XCNT(j)  (256  + 64 * (j))
#define XB_XSUB(j)  (1280 + 64 * (j))
#define XB_XGEN(j)  (2304 + 64 * (j))
#define XB_TOP      3328
#define XB_TOPGEN   3392
#define XCD_BAR_WORDS 3456
#define XB_SPIN_CAP (1u << 18)
__device__ __forceinline__ unsigned xb_ld(unsigned* p)              { return __hip_atomic_load(p, __ATOMIC_RELAXED, __HIP_MEMORY_SCOPE_AGENT); }
__device__ __forceinline__ unsigned xb_add(unsigned* p, unsigned v) { return __hip_atomic_fetch_add(p, v, __ATOMIC_RELAXED, __HIP_MEMORY_SCOPE_AGENT); }
__device__ __forceinline__ unsigned xb_xcc_id() { return (unsigned)__builtin_amdgcn_s_getreg((3 << 11) | 20) & 0xFu; }
#define XB_SPIN(cond, bar) do { unsigned _sp = 0; while (cond) { __builtin_amdgcn_s_sleep(1); \
    if ((++_sp & 255u) == 0u) { if (xb_ld(&(bar)[XB_TMO])) break; if (_sp > XB_SPIN_CAP) { atomicAdd(&(bar)[XB_TMO], 1u); break; } } } } while (0)
struct XcdBarrier { unsigned* bar; unsigned x; volatile LAS unsigned* st; };
__device__ __forceinline__ XcdBarrier xcd_barrier_post(unsigned* bar, volatile LAS unsigned* st) {
    XcdBarrier b; b.bar = bar; b.x = xb_xcc_id(); b.st = st;
    if (threadIdx.x == 0) (void)xb_add(&bar[XB_XCNT(b.x)], 1u);
    return b;
}
__device__ __forceinline__ void xcd_barrier_complete(unsigned* bar, unsigned x, unsigned& nloc, unsigned& nx) {
    const unsigned G = gridDim.x * gridDim.y * gridDim.z;
    unsigned sum, cnt, mine, sp = 0u;
    for (;;) {
        sum = 0u; cnt = 0u; mine = 0u;
#pragma unroll
        for (unsigned j = 0; j < 16; ++j) { const unsigned c = xb_ld(&bar[XB_XCNT(j)]); sum += c; cnt += (c > 0u) ? 1u : 0u; mine = (j == x) ? c : mine; }
        if (sum == G) break;
        __builtin_amdgcn_s_sleep(1);
        if ((++sp & 255u) == 0u) { if (xb_ld(&bar[XB_TMO])) break; if (sp > XB_SPIN_CAP) { atomicAdd(&bar[XB_TMO], 1u); break; } }
    }
    nloc = mine > 0u ? mine : 1u; nx = cnt > 0u ? cnt : 1u;
}
__device__ __forceinline__ void xcd_barrier(const XcdBarrier& b) {
    asm volatile("s_waitcnt vmcnt(0)" ::: "memory");
    __syncthreads();
    if (threadIdx.x == 0) {
        unsigned* bar = b.bar;
        __builtin_amdgcn_s_waitcnt(0);
        unsigned nloc = b.st[0], nx = b.st[1];
        if (nloc == 0u) { xcd_barrier_complete(bar, b.x, nloc, nx); b.st[0] = nloc; b.st[1] = nx; }
        const unsigned old = xb_add(&bar[XB_XSUB(b.x)], 1u);
        const unsigned gen = old / nloc;
        if (old + 1u == (gen + 1u) * nloc) {
            __builtin_amdgcn_fence(__ATOMIC_RELEASE, "agent");
            asm volatile("s_waitcnt vmcnt(0)" ::: "memory");
            const unsigned og = xb_add(&bar[XB_TOP], 1u);
            const unsigned tg = og / nx;
            if (og + 1u == (tg + 1u) * nx) xb_add(&bar[XB_TOPGEN], 1u);
            else XB_SPIN(xb_ld(&bar[XB_TOPGEN]) == tg, bar);
            __builtin_amdgcn_fence(__ATOMIC_ACQUIRE, "agent");
            xb_add(&bar[XB_XGEN(b.x)], 1u);
            asm volatile("s_waitcnt vmcnt(0)" ::: "memory");
        } else {
            XB_SPIN(xb_ld(&bar[XB_XGEN(b.x)]) == gen, bar);
            __builtin_amdgcn_fence(__ATOMIC_ACQUIRE, "agent");
            asm volatile("s_waitcnt vmcnt(0)" ::: "memory");
        }
    }
    __syncthreads();
}

struct Args { const float* in[20]; float* out; unsigned char* ws; };
typedef const __attribute__((address_space(4))) Args* KArgs;
#define GIN(i) ((const float*)(const GAS float*)(A->in[i]))
struct Frame { LAS unsigned char* lds; unsigned* ctl; unsigned char* ws; float* out; int tid, lane, wave, vcu, G; };

__device__ __forceinline__ float wave_sum(float v) {
#pragma unroll
    for (int o = 1; o < 64; o <<= 1) v += __shfl_xor(v, o);
    return v;
}
__device__ __forceinline__ float wave_max(float v) {
#pragma unroll
    for (int o = 1; o < 64; o <<= 1) v = fmaxf(v, __shfl_xor(v, o));
    return v;
}

__host__ __device__ __forceinline__ int rope_col(int d) { return (d & 64) | ((d & 31) << 1) | ((d >> 5) & 1); }
template <bool QKPERM>
__device__ __forceinline__ void p0_transpose_item(const float* W, int K, int N, bf16* WT, LAS float* scr, int item, int lane) {
    const int nblk = N / 32, kb = item / nblk, nb = item % nblk, k0 = 64 * kb, n0 = 32 * nb;
    float v[32];
#pragma unroll
    for (int i = 0; i < 32; ++i) { const int kk = 2 * i + (lane >> 5); v[i] = W[(size_t)(k0 + kk) * N + n0 + (lane & 31)]; }
#pragma unroll
    for (int i = 0; i < 32; ++i) { const int kk = 2 * i + (lane >> 5); scr[kk * 33 + (lane & 31)] = v[i]; }
    LDS_WAIT(); asm volatile("" ::: "memory");
    const int c = lane & 7;
#pragma unroll
    for (int j = 0; j < 4; ++j) { const int n = (lane >> 3) + 8 * j; const LAS float* s = scr + (8 * c) * 33 + n;
        v4u o; o.x = pk2(s[0 * 33], s[1 * 33]); o.y = pk2(s[2 * 33], s[3 * 33]); o.z = pk2(s[4 * 33], s[5 * 33]); o.w = pk2(s[6 * 33], s[7 * 33]);
        int nr = n0 + n; if (QKPERM && nr < 1280) nr = (nr & ~127) | rope_col(nr & 127);
        *(GAS v4u*)(WT + (size_t)nr * K + k0 + 8 * c) = o; }
    LDS_WAIT(); asm volatile("" ::: "memory");
}

__device__ __forceinline__ void mods_item(const Frame& F, KArgs A, const LAS float* sil, int mi) {
    const int l = mi / 96, cb = mi % 96; const int c4 = (F.lane & 31) * 4, kh = F.lane >> 5;
    const float* W = GIN(8) + (size_t)l * 2048 * 12288 + cb * 128 + c4;
    f32x4 a0 = {0.f, 0.f, 0.f, 0.f}, a1 = a0, a2 = a0;
    const float* Wp = W + (size_t)kh * 12288;
    for (int i0 = 0; i0 < 1024; i0 += 16) {
        f32x4 w[16];
#pragma unroll
        for (int j = 0; j < 16; ++j) w[j] = *(const f32x4*)(Wp + (size_t)(2 * j) * 12288);
        Wp += (size_t)32 * 12288;
#pragma unroll
        for (int j = 0; j < 16; ++j) { const int k = 2 * (i0 + j) + kh; a0 += sil[k] * w[j]; a1 += sil[2048 + k] * w[j]; a2 += sil[4096 + k] * w[j]; }
    }
#pragma unroll
    for (int e = 0; e < 4; ++e) { a0[e] += __shfl_xor(a0[e], 32); a1[e] += __shfl_xor(a1[e], 32); a2[e] += __shfl_xor(a2[e], 32); }
    if (F.lane < 32) {
        const f32x4 bias = *(const f32x4*)(GIN(9) + l * 12288 + cb * 128 + c4);
        float* M = (float*)(F.ws + WS_MODS) + (size_t)(l * 3) * 12288 + cb * 128 + c4;
        *(f32x4*)(M) = a0 + bias; *(f32x4*)(M + 12288) = a1 + bias; *(f32x4*)(M + 2 * 12288) = a2 + bias;
    }
}

__device__ __forceinline__ void p0_prologue(const Frame& F, KArgs A) {
    LAS float* sil = (LAS float*)(F.lds + 73728);
    for (int e = F.tid; e < 3 * 2048; e += 512) { const int j = e >> 11, k = e & 2047; const float c = (j == 0) ? GIN(7)[k] : GIN(6)[(j - 1) * 2048 + k]; sil[e] = c / (1.f + __expf(-c)); }
    __syncthreads();
    for (int mi = F.vcu + F.G * F.wave; mi < 384; mi += F.G * 8) mods_item(F, A, sil, mi);
    if (blockIdx.x == 0) {
        float* rope = (float*)(F.ws + WS_ROPE);
        for (int e = F.tid; e < 80 * 32; e += 512) { const int p = e >> 5, i = e & 31; const int pos = p < 16 ? p : p - 16;
            const float inv = exp2f(-(float)i * (13.287712379549449f / 32.f)); const float ang = (float)pos * inv;
            rope[2 * e] = cosf(ang); rope[2 * e + 1] = sinf(ang); }
        float* LB = (float*)(F.ws + WS_LB);
        for (int e = F.tid; e < 2048; e += 512) { const int dir = e >> 10, j = e & 1023; const float* lg = GIN(13) + (size_t)dir * 4096 + j;
            const float x0 = lg[0], x1 = lg[1024], x2 = lg[2048], x3 = lg[3072]; const float m = fmaxf(fmaxf(x0, x1), fmaxf(x2, x3));
            const float e0 = expf(x0 - m), e1 = expf(x1 - m), e2 = expf(x2 - m), e3 = expf(x3 - m); const float is = 1.f / (e0 + e1 + e2 + e3);
            float* o = LB + (size_t)dir * 4096 + j; o[0] = 0.f; o[1024] = e1 * is; o[2048] = (e1 + e2) * is; o[3072] = (e1 + e2 + e3) * is; }
    }
    {
        const int gt = F.vcu * 512 + F.tid, NGT = F.G * 512;
        for (int i = gt; i < 2 * 131072; i += NGT) { const bool isk = i < 131072; const int j = isk ? i : i - 131072; const float* src = (isk ? GIN(2) : GIN(3)) + (size_t)j * 8;
            const f32x4 x0 = *(const f32x4*)src, x1 = *(const f32x4*)(src + 4);
            if (isk) {
                bf16* dst = (bf16*)(F.ws + WS_CKB) + (((size_t)j * 8) & ~(size_t)127) + rope_col((j * 8) & 127);
                dst[0] = (bf16)f2bf(x0[0]); dst[2] = (bf16)f2bf(x0[1]); dst[4] = (bf16)f2bf(x0[2]); dst[6] = (bf16)f2bf(x0[3]);
                dst[8] = (bf16)f2bf(x1[0]); dst[10] = (bf16)f2bf(x1[1]); dst[12] = (bf16)f2bf(x1[2]); dst[14] = (bf16)f2bf(x1[3]);
            } else { v4u o; o.x = pk2(x0[0], x0[1]); o.y = pk2(x0[2], x0[3]); o.z = pk2(x1[0], x1[1]); o.w = pk2(x1[2], x1[3]); *(v4u*)((bf16*)(F.ws + WS_CVB) + (size_t)j * 8) = o; } }
    }
    LAS float* scr = (LAS float*)(F.lds + F.wave * 8704);
    const int gw = F.vcu * 8 + F.wave, NGW = F.G * 8;
    constexpr int I_IN = 32 * 208, I_O = 32 * 64, I_UP = 32 * 256, I_DN = 128 * 64, I_L = I_IN + I_O + I_UP + I_DN;
    for (int it = gw; it < 4 * I_L; it += NGW) {
        const int l = it / I_L; int r = it % I_L;
        if (r < I_IN) { p0_transpose_item<true>(GIN(10) + (size_t)l * 2048 * 6656, 2048, 6656, (bf16*)(F.ws + WS_WIN) + (size_t)l * 6656 * 2048, scr, r, F.lane); continue; } r -= I_IN;
        if (r < I_O) { p0_transpose_item<false>(GIN(15) + (size_t)l * 2048 * 2048, 2048, 2048, (bf16*)(F.ws + WS_WO) + (size_t)l * 2048 * 2048, scr, r, F.lane); continue; } r -= I_O;
        if (r < I_UP) { p0_transpose_item<false>(GIN(18) + (size_t)l * 2048 * 8192, 2048, 8192, (bf16*)(F.ws + WS_WUP) + (size_t)l * 8192 * 2048, scr, r, F.lane); continue; } r -= I_UP;
        { const int kb = r >> 6, nb = r & 63, ks = kb >> 5;
          p0_transpose_item<false>(GIN(19) + ((size_t)l * 8192 + (size_t)ks * 2048) * 2048, 2048, 2048, (bf16*)(F.ws + WS_WDN) + ((size_t)l * 4 + ks) * 2048 * 2048, scr, (kb & 31) * 64 + nb, F.lane); }
    }
}

__device__ __forceinline__ int cond_of_row(int r) { return r < NPR ? 0 : 1 + ((r - NPR) >> 10); }

__device__ __forceinline__ void modulate0_phase(const Frame& F, KArgs A) {
    const int gw = F.vcu * 8 + F.wave, NGW = F.G * 8; const float* MODS = (const float*)(F.ws + WS_MODS); bf16* H = (bf16*)(F.ws + WS_H);
    for (int r = gw; r < MT; r += NGW) {
        const float* xr = r < NPR ? GIN(0) + (size_t)r * DM : GIN(1) + (size_t)(r - NPR) * DM; const float* md = MODS + (size_t)cond_of_row(r) * 12288;
#pragma unroll
        for (int j = 0; j < 8; ++j) { const int c = (F.lane + 64 * j) * 4; const f32x4 x = *(const f32x4*)(xr + c), sc = *(const f32x4*)(md + 2048 + c), sh = *(const f32x4*)(md + c);
            const f32x4 h = x * (1.f + sc) + sh; v2u o; o.x = pk2(h[0], h[1]); o.y = pk2(h[2], h[3]); *(v2u*)(H + (size_t)r * DM + c) = o; }
    }
}

__device__ __forceinline__ void ln_phase(const Frame& F, KArgs A, int l, int which, int r_begin, int r_end, int gw, int NGW) {
    const float* MODS = (const float*)(F.ws + WS_MODS); bf16* H = (bf16*)(F.ws + WS_H);
    const float* Y = (const float*)(F.ws + WS_Y); const bool last = (which == 1 && l == 3); float* X = last ? F.out : (float*)(F.ws + WS_X);
    const float* lg = GIN(16) + (size_t)(l * 2 + which) * DM; const float* lb = GIN(17) + (size_t)(l * 2 + which) * DM;
    for (int r = r_begin + gw; r < r_end; r += NGW) {
        const float* yr = (which == 1 ? (const float*)(F.ws + WS_X) : Y) + (size_t)r * DM; f32x4 v[8]; float s = 0.f;
#pragma unroll
        for (int j = 0; j < 8; ++j) { v[j] = *(const f32x4*)(yr + (F.lane + 64 * j) * 4);
            if (which == 1) {
                v[j] = v[j] * DN_ALPHA;
                const bf16* sl = (const bf16*)(F.ws + WS_SL) + (size_t)r * DM + (F.lane + 64 * j) * 4;
#pragma unroll
                for (int k = 0; k < 4; ++k) { const v2u w = *(const v2u*)(sl + (size_t)k * MT * DM); v[j][0] += bflo(w.x); v[j][1] += bfhi(w.x); v[j][2] += bflo(w.y); v[j][3] += bfhi(w.y); } }
            s += (v[j][0] + v[j][1]) + (v[j][2] + v[j][3]); }
        const float mean = wave_sum(s) * (1.f / DM); float s2 = 0.f;
#pragma unroll
        for (int j = 0; j < 8; ++j) { v[j] = v[j] - mean; s2 += (v[j][0] * v[j][0] + v[j][1] * v[j][1]) + (v[j][2] * v[j][2] + v[j][3] * v[j][3]); }
        const float rstd = 1.f / sqrtf(wave_sum(s2) * (1.f / DM) + LN_EPS);
        const int cond = cond_of_row(r);
        const float* msc = which == 0 ? MODS + (size_t)(l * 3 + cond) * 12288 + 8192 : MODS + (size_t)((l + 1) * 3 + cond) * 12288 + 2048;
        const float* msh = which == 0 ? MODS + (size_t)(l * 3 + cond) * 12288 + 6144 : MODS + (size_t)((l + 1) * 3 + cond) * 12288;
#pragma unroll
        for (int j = 0; j < 8; ++j) { const int c = (F.lane + 64 * j) * 4; const f32x4 g = *(const f32x4*)(lg + c), b = *(const f32x4*)(lb + c);
            const f32x4 x = v[j] * rstd * g + b; *(f32x4*)(X + (size_t)r * DM + c) = x;
            if (!last) { const f32x4 sc = *(const f32x4*)(msc + c), sh = *(const f32x4*)(msh + c); const f32x4 h = x * (1.f + sc) + sh;
                v2u o; o.x = pk2(h[0], h[1]); o.y = pk2(h[2], h[3]); *(v2u*)(H + (size_t)r * DM + c) = o; } }
    }
}

namespace pg8 {
__device__ __forceinline__ void tile_of(int wgid, int nM, int nN, int& pm, int& pn) {
    const int nig = WGM * nN, gid = wgid / nig, fm = gid * WGM, gsz = (nM - fm) < WGM ? (nM - fm) : WGM;
    pm = fm + ((wgid % nig) % gsz); pn = (wgid % nig) / gsz;
}
struct InOrder {
    int G, c;
    __device__ __forceinline__ bool next(int i, Unit& u) const {
        const int L = i * G + c; if (L >= 1024) return false;
        const int wgid = (L & 7) * 128 + (L >> 3);
        if (wgid < 880) tile_of(wgid, 40, 22, u.pm, u.pn); else { tile_of(wgid - 880, 36, 4, u.pm, u.pn); u.pn += 22; }
        u.ks = 0; return true;
    }
    __device__ __forceinline__ void a_ready(const Unit&) const {}
    __device__ __forceinline__ void done(const Unit&) const {}
};
struct OneUnit {
    int pm, pn;
    __device__ __forceinline__ bool next(int i, Unit& u) const { if (i) return false; u.pm = pm; u.pn = pn; u.ks = 0; return true; }
    __device__ __forceinline__ void a_ready(const Unit&) const {}
    __device__ __forceinline__ void done(const Unit&) const {}
};
struct SplitOrder : StaticOrder {
    __device__ __forceinline__ bool next(int i, Unit& u) const { if (!StaticOrder::next(i, u)) return false; u.ks = u.pn >> 3; u.pn &= 7; return true; }
};
struct EpiIn {
    static constexpr bool PERM = true, AFTER_DRAIN = false;
    bf16_t *Q, *KB, *VB, *HQ, *HI, *HG; float *ZF, *ZB, *outK, *outV; const float* rope;
    __device__ __forceinline__ void operator()(const f32x4 (&acc)[2][2][4][2], const Unit& u, int wr, int wc, int fr, int fq) const {
        const int pn = u.pn, rbase = u.pm * BM + wr * 64 + fr, cl = wc * 32 + 8 * fq;
        if (pn >= 10 && pn < 18) {
            float* dst = (pn < 14 ? ZF + (pn - 10) * 256 : ZB + (pn - 14) * 256) + cl;
#pragma unroll
            for (int ai = 0; ai < 2; ++ai)
#pragma unroll
                for (int m = 0; m < 4; ++m) { float* rowp = dst + (size_t)(rbase + ai * HALF + m * 16) * 1024;
#pragma unroll
                    for (int bj = 0; bj < 2; ++bj) { *(f32x4*)(rowp + bj * HALF) = acc[ai][bj][m][0]; *(f32x4*)(rowp + bj * HALF + 4) = acc[ai][bj][m][1]; } }
        } else {
            bf16_t* dst; int ld = 1024; bool act = false; float* of = nullptr;
            if (pn < 4) dst = Q + pn * 256;
            else if (pn == 4) { dst = KB; ld = 256; of = outK; }
            else if (pn == 5) { dst = VB; ld = 256; of = outV; }
            else if (pn < 10) { dst = HQ + (pn - 6) * 256; act = true; }
            else if (pn < 22) dst = HI + (pn - 18) * 256;
            else { dst = HG + (pn - 22) * 256; act = true; }
            if (u.pm >= 32) of = nullptr;
            const bool qk = pn <= 4, rot = qk && u.pm >= 32; const int half = wc >> 1, i0 = (wc & 1) * 16 + 4 * fq;
#pragma unroll
            for (int ai = 0; ai < 2; ++ai)
#pragma unroll
                for (int m = 0; m < 4; ++m) { const int row = rbase + ai * HALF + m * 16; bf16_t* rowp = dst + (size_t)row * ld + cl;
#pragma unroll
                    for (int bj = 0; bj < 2; ++bj) { f32x4 v0 = acc[ai][bj][m][0], v1 = acc[ai][bj][m][1];
                        if (rot) { const int t = (row - 8192) & 1023; const int p = half ? 16 + (t & 63) : (t >> 6); const float* rp = rope + (size_t)(p * 32 + i0) * 2;
                            const f32x4 r0 = *(const f32x4*)rp, r1 = *(const f32x4*)(rp + 4);
                            v0 = (f32x4){v0[0] * r0[0] - v0[1] * r0[1], v0[0] * r0[1] + v0[1] * r0[0], v0[2] * r0[2] - v0[3] * r0[3], v0[2] * r0[3] + v0[3] * r0[2]};
                            v1 = (f32x4){v1[0] * r1[0] - v1[1] * r1[1], v1[0] * r1[1] + v1[1] * r1[0], v1[2] * r1[2] - v1[3] * r1[3], v1[2] * r1[3] + v1[3] * r1[2]}; }
                        if (of) { float* op = of + (size_t)u.pm * 262144 + (size_t)(row - u.pm * BM) * 256 + bj * HALF;
                            if (pn == 4) { op += half * 64 + i0; *(f32x4*)op = (f32x4){v0[0], v0[2], v1[0], v1[2]}; *(f32x4*)(op + 32) = (f32x4){v0[1], v0[3], v1[1], v1[3]}; }
                            else { op += cl; *(f32x4*)op = v0; *(f32x4*)(op + 4) = v1; } }
                        if (act) {
#pragma unroll
                            for (int e = 0; e < 4; ++e) { v0[e] = siluf(v0[e]); v1[e] = siluf(v1[e]); } }
                        u32x4 w; w.x = cvt_pk_bf16(v0[0], v0[1]); w.y = cvt_pk_bf16(v0[2], v0[3]); w.z = cvt_pk_bf16(v1[0], v1[1]); w.w = cvt_pk_bf16(v1[2], v1[3]);
                        *(u32x4*)(rowp + bj * HALF) = w; } }
        }
    }
};
struct EpiRes {
    static constexpr bool PERM = false, AFTER_DRAIN = false;
    const float* xp; const float* xs; float* Y; const float* gate0;
    __device__ __forceinline__ void operator()(const f32x4 (&acc)[2][2][4][2], const Unit& u, int wr, int wc, int fr, int fq) const {
        const int cond = u.pm < 32 ? 0 : 1 + ((u.pm - 32) >> 2); const float* gate = gate0 + (size_t)cond * 12288;
        const int col0 = u.pn * BM + wc * 32 + 4 * fq; const int r0 = u.pm * BM + wr * 64 + fr;
        const float* __restrict__ xb = (u.pm < 32 ? xp + (size_t)r0 * 2048 : xs + (size_t)(r0 - 8192) * 2048) + col0; float* __restrict__ yb = Y + (size_t)r0 * 2048 + col0;
        f32x4 gv[2][2];
#pragma unroll
        for (int bj = 0; bj < 2; ++bj)
#pragma unroll
            for (int n = 0; n < 2; ++n) gv[bj][n] = *(const f32x4*)(gate + col0 + bj * HALF + n * 16);
        f32x4 xc[2][2], xn[2][2];
#pragma unroll
        for (int bj = 0; bj < 2; ++bj)
#pragma unroll
            for (int n = 0; n < 2; ++n) xc[bj][n] = *(const f32x4*)(xb + bj * HALF + n * 16);
#pragma unroll
        for (int it = 0; it < 8; ++it) { const int ai = it >> 2, m = it & 3; const size_t ro = (size_t)(ai * HALF + m * 16) * 2048;
            if (it < 7) { const int ai2 = (it + 1) >> 2, m2 = (it + 1) & 3; const size_t rn = (size_t)(ai2 * HALF + m2 * 16) * 2048;
#pragma unroll
                for (int bj = 0; bj < 2; ++bj)
#pragma unroll
                    for (int n = 0; n < 2; ++n) xn[bj][n] = *(const f32x4*)(xb + rn + bj * HALF + n * 16); }
#pragma unroll
            for (int bj = 0; bj < 2; ++bj)
#pragma unroll
                for (int n = 0; n < 2; ++n) { *(f32x4*)(yb + ro + bj * HALF + n * 16) = DN_ALPHA * xc[bj][n] + gv[bj][n] * acc[ai][bj][m][n]; xc[bj][n] = xn[bj][n]; } }
    }
};
struct EpiDown {
    static constexpr bool PERM = true, AFTER_DRAIN = false;
    bf16_t* SL; const float* gate0;
    __device__ __forceinline__ void operator()(const f32x4 (&acc)[2][2][4][2], const Unit& u, int wr, int wc, int fr, int fq) const {
        const int cond = u.pm < 32 ? 0 : 1 + ((u.pm - 32) >> 2); const float* gate = gate0 + (size_t)cond * 12288;
        const int col0 = u.pn * BM + wc * 32 + 8 * fq; const int r0 = u.pm * BM + wr * 64 + fr;
        f32x4 gv[2][2];
#pragma unroll
        for (int bj = 0; bj < 2; ++bj)
#pragma unroll
            for (int n = 0; n < 2; ++n) gv[bj][n] = *(const f32x4*)(gate + col0 + bj * HALF + n * 4);
        bf16_t* sl = SL + (size_t)u.ks * MT * 2048;
#pragma unroll
        for (int ai = 0; ai < 2; ++ai)
#pragma unroll
            for (int m = 0; m < 4; ++m) { bf16_t* sr = sl + (size_t)(r0 + ai * HALF + m * 16) * 2048 + col0;
#pragma unroll
                for (int bj = 0; bj < 2; ++bj) { const f32x4 v0 = gv[bj][0] * acc[ai][bj][m][0], v1 = gv[bj][1] * acc[ai][bj][m][1];
                    u32x4 w; w.x = cvt_pk_bf16(v0[0], v0[1]); w.y = cvt_pk_bf16(v0[2], v0[3]); w.z = cvt_pk_bf16(v1[0], v1[1]); w.w = cvt_pk_bf16(v1[2], v1[3]);
                    *(u32x4*)(sr + bj * HALF) = w; } }
    }
};
struct EpiUp {
    static constexpr bool PERM = true, AFTER_DRAIN = false;
    bf16_t* O;
    __device__ __forceinline__ void operator()(const f32x4 (&acc)[2][2][4][2], const Unit& u, int wr, int wc, int fr, int fq) const {
        const int row0 = u.pm * BM + wr * 64 + fr, col0 = (u.pn & 7) * BM + wc * 32 + 8 * fq;
        bf16_t* Ob = O + (size_t)(u.pn >> 3) * MT * 2048;
#pragma unroll
        for (int ai = 0; ai < 2; ++ai)
#pragma unroll
            for (int m = 0; m < 4; ++m) { bf16_t* rowp = Ob + (size_t)(row0 + ai * HALF + m * 16) * 2048 + col0;
#pragma unroll
                for (int bj = 0; bj < 2; ++bj) { f32x4 v0 = acc[ai][bj][m][0], v1 = acc[ai][bj][m][1];
#pragma unroll
                    for (int e = 0; e < 4; ++e) { const float a = fmaxf(v0[e], 0.f), b = fmaxf(v1[e], 0.f); v0[e] = a * a; v1[e] = b * b; }
                    u32x4 w; w.x = cvt_pk_bf16(v0[0], v0[1]); w.y = cvt_pk_bf16(v0[2], v0[3]); w.z = cvt_pk_bf16(v1[0], v1[1]); w.w = cvt_pk_bf16(v1[2], v1[3]);
                    *(u32x4*)(rowp + bj * HALF) = w; } }
    }
};
}

__device__ __forceinline__ void attn_task(const Frame& F, KArgs A, int l, int task, char* lds_gen) {
    const att::bf16* QB = (const att::bf16*)(F.ws + WS_QB); const att::bf16* KB = (const att::bf16*)(F.ws + WS_KB); const att::bf16* VB = (const att::bf16*)(F.ws + WS_VB);
    att::bf16* ATT = (att::bf16*)(F.ws + WS_ATT);
    const bool lat = task < 64;
    int h, row0, q0, kstart, nloc, sb = 0;
    if (lat) { sb = task >> 5; h = (task >> 2) & 7; const int qb = task & 3; row0 = NPR + sb * 1024; q0 = qb * 256;
        kstart = q0 - 128 < 0 ? 0 : q0 - 128; const int kend = q0 + 384 > 1024 ? 1024 : q0 + 384; nloc = (kend - kstart) >> 6; }
    else { const int t2 = task - 64; h = t2 & 7; row0 = (t2 >> 3) * 256; q0 = 0; kstart = 0; nloc = 4; }
    const int g = h >> 2;
    const size_t coff = (size_t)((sb * 4 + l) * 512) * 256 + g * 128;
    const att::bf16* Kl = KB + (size_t)(row0 + kstart) * 256 + g * 128; const att::bf16* Vl = VB + (size_t)(row0 + kstart) * 256 + g * 128;
    const att::bf16* Kc = lat ? (const att::bf16*)(F.ws + WS_CKB) + coff : Kl; const att::bf16* Vc = lat ? (const att::bf16*)(F.ws + WS_CVB) + coff : Vl;
    const float sink = GIN(11)[l * 8 + h];
    att::attn_body(QB + (size_t)(row0 + q0) * 1024 + h * 128, Kl, Vl, Kc, Vc, lat ? nloc + 8 : 4, nloc, lat, kstart, q0, sink * 1.4426950408889634f,
                   ATT + (size_t)(row0 + q0) * 1024 + h * 128, lds_gen, F.tid);
}

__device__ __forceinline__ void hgrn_task(const Frame& F, KArgs A, int l, int u) {
    const bool samp = u < 32; const int v = samp ? u : u - 32; const int bidx = v >> 4, h = (v >> 1) & 7, dir = v & 1; const int T = samp ? 1024 : 256; const int row0 = samp ? NPR + bidx * 1024 : bidx * 256;
    const float* LB = (const float*)(F.ws + WS_LB); const size_t soff = ((size_t)((bidx * 4 + l) * 8 + h)) * 16384;
    hg::hgrn_body(F.lds, F.tid, F.wave, (const float*)(F.ws + (dir ? WS_ZB : WS_ZF)), (const hg::bf16*)(F.ws + WS_HQ), (const hg::bf16*)(F.ws + WS_HI),
                  (hg::bf16*)(F.ws + (dir ? WS_OB : WS_OF)), LB + (size_t)(dir * 4 + l) * 1024 + h * 128,
                  samp ? (dir ? GIN(5) : GIN(4)) + soff : nullptr, samp ? nullptr : F.out + (dir ? OUT_SB : OUT_SF) + soff, row0, T, h * 128, dir);
}

__device__ __forceinline__ void mix_phase(const Frame& F, KArgs A, int l) {
    const int gw = F.vcu * 8 + F.wave, NGW = F.G * 8; bf16* MIX = (bf16*)(F.ws + WS_MIX);
    const bf16* ATT = (const bf16*)(F.ws + WS_ATT); const bf16* OFp = (const bf16*)(F.ws + WS_OF); const bf16* OBp = (const bf16*)(F.ws + WS_OB); const bf16* HG = (const bf16*)(F.ws + WS_HG);
    const float* ag = GIN(12) + (size_t)l * 1024 + F.lane * 16; const float* hgn = GIN(14) + (size_t)l * 128 + (F.lane & 7) * 16;
#define UNPK8(W_, o) do { const v4u w_ = (W_); o[0] = (f32x4){bflo(w_.x), bfhi(w_.x), bflo(w_.y), bfhi(w_.y)}; o[1] = (f32x4){bflo(w_.z), bfhi(w_.z), bflo(w_.w), bfhi(w_.w)}; } while (0)
    for (int r = gw; r < MT; r += NGW) {
        const size_t ro = (size_t)r * 1024 + F.lane * 16;
        f32x4 a[4]; float ss = 0.f;
        { const v4u wA = *(const v4u*)(ATT + ro), wB = *(const v4u*)(ATT + ro + 8); UNPK8(wA, (a + 0)); UNPK8(wB, (a + 2)); }
#pragma unroll
        for (int j = 0; j < 4; ++j) ss += (a[j][0] * a[j][0] + a[j][1] * a[j][1]) + (a[j][2] * a[j][2] + a[j][3] * a[j][3]);
        const float rs = 1.f / sqrtf(wave_sum(ss) * (1.f / 1024.f) + RMS_EPS);
        v4u w0, w1;
        { const f32x4 g0 = *(const f32x4*)(ag), g1 = *(const f32x4*)(ag + 4), g2 = *(const f32x4*)(ag + 8), g3 = *(const f32x4*)(ag + 12);
          const f32x4 y0 = a[0] * rs * g0, y1 = a[1] * rs * g1, y2 = a[2] * rs * g2, y3 = a[3] * rs * g3;
          w0.x = pk2(y0[0], y0[1]); w0.y = pk2(y0[2], y0[3]); w0.z = pk2(y1[0], y1[1]); w0.w = pk2(y1[2], y1[3]);
          w1.x = pk2(y2[0], y2[1]); w1.y = pk2(y2[2], y2[3]); w1.z = pk2(y3[0], y3[1]); w1.w = pk2(y3[2], y3[3]); }
        *(v4u*)(MIX + (size_t)r * 2048 + F.lane * 16) = w0; *(v4u*)(MIX + (size_t)r * 2048 + F.lane * 16 + 8) = w1;
        float s2 = 0.f;
        { const v4u fA = *(const v4u*)(OFp + ro), fB = *(const v4u*)(OFp + ro + 8), bA = *(const v4u*)(OBp + ro), bB = *(const v4u*)(OBp + ro + 8);
          f32x4 t[4]; UNPK8(fA, (a + 0)); UNPK8(fB, (a + 2)); UNPK8(bA, (t + 0)); UNPK8(bB, (t + 2));
#pragma unroll
          for (int j = 0; j < 4; ++j) { a[j] += t[j]; s2 += (a[j][0] * a[j][0] + a[j][1] * a[j][1]) + (a[j][2] * a[j][2] + a[j][3] * a[j][3]); } }
        s2 += __shfl_xor(s2, 1); s2 += __shfl_xor(s2, 2); s2 += __shfl_xor(s2, 4);
        const float r2 = 1.f / sqrtf(s2 * (1.f / 128.f) + RMS_EPS);
        const v4u gA = *(const v4u*)(HG + ro), gB = *(const v4u*)(HG + ro + 8);
        { const f32x4 g0 = *(const f32x4*)(hgn), g1 = *(const f32x4*)(hgn + 4), g2 = *(const f32x4*)(hgn + 8), g3 = *(const f32x4*)(hgn + 12);
          f32x4 t[4]; UNPK8(gA, (t + 0)); UNPK8(gB, (t + 2));
          const f32x4 y0 = a[0] * r2 * g0 * t[0], y1 = a[1] * r2 * g1 * t[1], y2 = a[2] * r2 * g2 * t[2], y3 = a[3] * r2 * g3 * t[3];
          w0.x = pk2(y0[0], y0[1]); w0.y = pk2(y0[2], y0[3]); w0.z = pk2(y1[0], y1[1]); w0.w = pk2(y1[2], y1[3]);
          w1.x = pk2(y2[0], y2[1]); w1.y = pk2(y2[2], y2[3]); w1.z = pk2(y3[0], y3[1]); w1.w = pk2(y3[2], y3[3]); }
        *(v4u*)(MIX + (size_t)r * 2048 + 1024 + F.lane * 16) = w0; *(v4u*)(MIX + (size_t)r * 2048 + 1024 + F.lane * 16 + 8) = w1;
    }
#undef UNPK8
}

__global__ void __launch_bounds__(512, 2) fwd_kernel(Args A_byval) {
    KArgs A = (KArgs)__builtin_amdgcn_kernarg_segment_ptr();
    extern __shared__ __attribute__((aligned(16))) unsigned char lds_raw[];
    Frame F;
    F.lds = (LAS unsigned char*)lds_raw; F.ws = (unsigned char*)(GAS unsigned char*)A->ws; F.out = (float*)(GAS float*)A->out; F.ctl = (unsigned*)(F.ws + WS_CTL);
    F.tid = threadIdx.x; F.lane = F.tid & 63; F.wave = __builtin_amdgcn_readfirstlane(F.tid >> 6);
    F.G = gridDim.x; { const int bx = blockIdx.x; F.vcu = (F.G % 8 == 0) ? (bx % 8) * (F.G / 8) + bx / 8 : bx; }
    volatile LAS unsigned* MISC = (volatile LAS unsigned*)(F.lds + MISC_OFF);
    for (int u = F.tid; u < (LDS_BYTES - LDSCTL_OFF) / 4; u += 512) ((LAS unsigned*)(F.lds + LDSCTL_OFF))[u] = 0u;
    __syncthreads();
    (void)xcd_barrier_post(F.ctl + CW_BAR, MISC + 8);
#define PHASE_BEGIN() do { int t_o = threadIdx.x; asm volatile("" : "+v"(t_o)); F.tid = t_o; F.lane = t_o & 63; F.wave = __builtin_amdgcn_readfirstlane(t_o >> 6); } while (0)
#define GRID_BAR() do { unsigned char* w_ = F.ws; asm volatile("" : "+s"(w_)); XcdBarrier b_; b_.bar = (unsigned*)(w_ + WS_CTL) + CW_BAR; b_.x = xb_xcc_id(); b_.st = MISC + 8; xcd_barrier(b_); } while (0)
    unsigned char* ws = F.ws;
    using pg8::bf16_t;

    p0_prologue(F, A);
    GRID_BAR(); PHASE_BEGIN();
    modulate0_phase(F, A);
    GRID_BAR(); PHASE_BEGIN();

    for (int l = 0; l < 4; ++l) {
        { int t_o = threadIdx.x; asm volatile("" : "+v"(t_o)); F.tid = t_o; F.lane = t_o & 63; F.wave = __builtin_amdgcn_readfirstlane(t_o >> 6); asm volatile("" : "+s"(A)); ws = (unsigned char*)(GAS unsigned char*)A->ws; F.ws = ws; F.out = (float*)(GAS float*)A->out; F.ctl = (unsigned*)(ws + WS_CTL); }
        const float* MODS_L = (const float*)(ws + WS_MODS) + (size_t)l * 3 * 12288;
        { pg8::Gemm g{(const bf16_t*)(ws + WS_H), (const bf16_t*)(ws + WS_WIN) + (size_t)l * IN_DIM * DM, MT, IN_DIM, DM, DM, 0, 0}; pg8::InOrder S{F.G, (int)blockIdx.x};
          pg8::EpiIn E{(bf16_t*)(ws + WS_QB), (bf16_t*)(ws + WS_KB), (bf16_t*)(ws + WS_VB), (bf16_t*)(ws + WS_HQ), (bf16_t*)(ws + WS_HI), (bf16_t*)(ws + WS_HG),
                       (float*)(ws + WS_ZF), (float*)(ws + WS_ZB), F.out + OUT_CK + (size_t)l * 65536, F.out + OUT_CV + (size_t)l * 65536, (const float*)(ws + WS_ROPE)};
          pg8::gemm_phase<pg8::EpiIn, pg8::InOrder, true, true>(F.lds, g, S, E); }
        GRID_BAR(); PHASE_BEGIN();
        for (;;) {
            if (F.tid == 0) MISC[0] = atomicAdd(F.ctl + CW_Q + 64 * l, 1u);
            __syncthreads();
            const int u = (int)MISC[0];
            __syncthreads();
            if (u >= 880) break;
            PHASE_BEGIN();
            if (u < 16) {
                pg8::Gemm g{(const bf16_t*)(ws + WS_H), (const bf16_t*)(ws + WS_WIN) + (size_t)l * IN_DIM * DM, MT, IN_DIM, DM, DM, 0, 0}; pg8::OneUnit S1{36 + (u >> 2), 22 + (u & 3)};
                pg8::EpiIn E{(bf16_t*)(ws + WS_QB), (bf16_t*)(ws + WS_KB), (bf16_t*)(ws + WS_VB), (bf16_t*)(ws + WS_HQ), (bf16_t*)(ws + WS_HI), (bf16_t*)(ws + WS_HG),
                             (float*)(ws + WS_ZF), (float*)(ws + WS_ZB), F.out + OUT_CK + (size_t)l * 65536, F.out + OUT_CV + (size_t)l * 65536, (const float*)(ws + WS_ROPE)};
                pg8::gemm_phase<pg8::EpiIn, pg8::OneUnit, true, true>(F.lds, g, S1, E);
            }
            else if (u < 48) hgrn_task(F, A, l, u - 16); else if (u >= 112 && u < 624) hgrn_task(F, A, l, u - 80);
            else if (u >= 48 && u < 112) attn_task(F, A, l, u - 48, (char*)lds_raw); else if (u >= 624) attn_task(F, A, l, u - 560, (char*)lds_raw);
        }
        GRID_BAR(); PHASE_BEGIN();
        mix_phase(F, A, l);
        GRID_BAR(); PHASE_BEGIN();
        { pg8::Gemm g{(const bf16_t*)(ws + WS_MIX), (const bf16_t*)(ws + WS_WO) + (size_t)l * DM * DM, MT, DM, DM, DM, 0, 0};
          const float* xp = l == 0 ? GIN(0) : (const float*)(ws + WS_X); const float* xs = l == 0 ? GIN(1) : (const float*)(ws + WS_X) + (size_t)NPR * DM;
          pg8::EpiRes E{xp, xs, (float*)(ws + WS_Y), MODS_L + 4096};
          { pg8::StaticOrder S; S.init(NPR, DM, F.G, (int)blockIdx.x); pg8::gemm_phase<pg8::EpiRes, pg8::StaticOrder, true, true>(F.lds, g, S, E); }
          GRID_BAR(); PHASE_BEGIN();
          if (F.G >= 128) {
              if (blockIdx.x < 64) { pg8::OneUnit S1{32 + ((int)blockIdx.x >> 3), (int)blockIdx.x & 7}; pg8::gemm_phase<pg8::EpiRes, pg8::OneUnit, true, true>(F.lds, g, S1, E); }
              else ln_phase(F, A, l, 0, 0, NPR, ((int)blockIdx.x - 64) * 8 + F.wave, (F.G - 64) * 8);
          } else {
              for (int uu = (int)blockIdx.x; uu < 64; uu += F.G) { pg8::OneUnit S1{32 + (uu >> 3), uu & 7}; pg8::gemm_phase<pg8::EpiRes, pg8::OneUnit, true, true>(F.lds, g, S1, E); }
              ln_phase(F, A, l, 0, 0, NPR, F.vcu * 8 + F.wave, F.G * 8);
          }
        }
        GRID_BAR(); PHASE_BEGIN();
        ln_phase(F, A, l, 0, NPR, MT, F.vcu * 8 + F.wave, F.G * 8);
        GRID_BAR(); PHASE_BEGIN();
        { pg8::Gemm g{(const bf16_t*)(ws + WS_H), (const bf16_t*)(ws + WS_WUP) + (size_t)l * DFF * DM, MT, DFF, DM, DM, 0, 0}; pg8::StaticOrder S; S.init(MT, DFF, F.G, (int)blockIdx.x);
          pg8::EpiUp E{(bf16_t*)(ws + WS_ACT)};
          pg8::gemm_phase<pg8::EpiUp, pg8::StaticOrder, true, true>(F.lds, g, S, E); }
        GRID_BAR(); PHASE_BEGIN();
        { pg8::Gemm g{(const bf16_t*)(ws + WS_ACT), (const bf16_t*)(ws + WS_WDN) + (size_t)l * DM * DFF, MT, DM, 2048, 2048, (size_t)MT * 2048 * 2, (size_t)2048 * 2048 * 2}; pg8::SplitOrder S; S.init(MT, 8192, F.G, (int)blockIdx.x);
          pg8::EpiDown E{(bf16_t*)(ws + WS_SL), MODS_L + 10240};
          pg8::gemm_phase<pg8::EpiDown, pg8::SplitOrder, true, true>(F.lds, g, S, E); }
        GRID_BAR(); PHASE_BEGIN();
        ln_phase(F, A, l, 1, 0, MT, F.vcu * 8 + F.wave, F.G * 8);
        GRID_BAR(); PHASE_BEGIN();
    }
}

extern "C" void kernel_launch(void* const* d_in, const int* in_sizes, int n_in, void* d_out, int out_size, void* d_ws, size_t ws_size, hipStream_t stream) {
    static int grid = 0;
    if (grid == 0) {
        if (n_in != 20 || ws_size < WS_END) { fprintf(stderr, "kernel_launch: unexpected n_in %d / ws %zu\n", n_in, ws_size); grid = -1; return; }
        int dev = 0, cus = 0, per_cu = 0;
        if (hipGetDevice(&dev) != hipSuccess || hipDeviceGetAttribute(&cus, hipDeviceAttributeMultiprocessorCount, dev) != hipSuccess) { grid = -1; return; }
        if (hipFuncSetAttribute((const void*)fwd_kernel, hipFuncAttributeMaxDynamicSharedMemorySize, LDS_BYTES) != hipSuccess) { fprintf(stderr, "kernel_launch: hipFuncSetAttribute failed\n"); grid = -1; return; }
        if (hipOccupancyMaxActiveBlocksPerMultiprocessor(&per_cu, (const void*)fwd_kernel, 512, LDS_BYTES) != hipSuccess || per_cu < 1) fprintf(stderr, "kernel_launch: occupancy query says %d\n", per_cu);
        (void)hipGetLastError();
        grid = cus;
    }
    if (grid < 0) return;
    if (hipMemsetAsync((char*)d_ws + WS_CTL, 0, CTL_ZERO_BYTES, stream) != hipSuccess) return;
    Args a{};
    for (int i = 0; i < 20; ++i) a.in[i] = (const float*)d_in[i];
    a.out = (float*)d_out; a.ws = (unsigned char*)d_ws;
    hipLaunchKernelGGL(fwd_kernel, dim3(grid), dim3(512), LDS_BYTES, stream, a);
}
```

```cpp
#include <hip/hip_runtime.h>
#include <cstdio>
#include <cstdint>
namespace pg8 {
#define PG8_LAS __attribute__((address_space(3)))
typedef unsigned short bf16_t;
typedef short bf16x8 __attribute__((ext_vector_type(8)));
typedef float f32x4 __attribute__((ext_vector_type(4)));
typedef unsigned u32x4 __attribute__((ext_vector_type(4)));
constexpr int BM = 256, BK = 64, HALF = 128, HTB = HALF * BK * 2  , STAGE_BYTES = 8 * HTB, NXCD = 8, WGM = 8;

__host__ __device__ __forceinline__ int lds_byte(int r, int c) { const int st = (r >> 4) * 2 + (c >> 5), rr = r & 15, cc = c & 31, ob = rr * 64 + cc * 2; return st * 1024 + (ob ^ (((ob >> 9) & 1) << 5)); }
__host__ __device__ __forceinline__ void stage_rc(int b, int& R, int& C) { const int st = b / 1024, sb = b % 1024, swz = sb ^ (((sb >> 9) & 1) << 5); R = (st >> 1) * 16 + swz / 64; C = (st & 1) * 32 + (swz % 64) / 2; }
__host__ __device__ __forceinline__ int perm32(int rho) { const int n = rho >> 4, i = rho & 15; return 8 * (i >> 2) + 4 * n + (i & 3); }

struct Unit { int pm, pn, ks; };
struct Gemm { const bf16_t* A; const bf16_t* Bt; int M, N, K, ld; size_t ksA, ksB; };

struct StaticOrder {
    int nM, nN, nwg, G, c;
    __host__ __device__ void init(int M, int N, int G_, int c_) { nM = M / BM; nN = N / BM; nwg = nM * nN; G = G_; c = c_; }
    __host__ __device__ bool next(int i, Unit& u) const {
        const long L = (long)i * G + c; if (L >= nwg) return false;
        int wgid = (int)L; { const int q = nwg / NXCD, r = nwg % NXCD, xcd = wgid % NXCD, off = wgid / NXCD; wgid = (xcd < r ? xcd * (q + 1) : r * (q + 1) + (xcd - r) * q) + off; }
        const int nig = WGM * nN, gid = wgid / nig, fm = gid * WGM, gsz = (nM - fm) < WGM ? (nM - fm) : WGM;
        u.pm = fm + ((wgid % nig) % gsz); u.pn = (wgid % nig) / gsz; u.ks = 0; return true;
    }
    __device__ __forceinline__ void a_ready(const Unit&) const {}
    __device__ __forceinline__ void done(const Unit&) const {}
};

__device__ __forceinline__ unsigned cvt_pk_bf16(float lo, float hi) { unsigned r; asm volatile("v_cvt_pk_bf16_f32 %0, %1, %2" : "=v"(r) : "v"(lo), "v"(hi)); return r; }
template <class Epi, class Sched, bool ALIGN_EPI = false, bool SP2 = false>
__device__ __forceinline__ void gemm_phase(PG8_LAS unsigned char* lds, const Gemm g, const Sched& S, const Epi& E) {
    int tid_o = threadIdx.x; asm volatile("" : "+v"(tid_o));
    const int tid = tid_o, wid = __builtin_amdgcn_readfirstlane(tid >> 6), lane = tid & 63, wr = wid >> 2, wc = wid & 3, fr = lane & 15, fq = lane >> 4;
    const int K = g.K, nt = K / BK, LD = g.ld;
    unsigned voffA[2], voffB[2];
#pragma unroll
    for (int i = 0; i < 2; ++i) { int R, C; stage_rc(tid * 16 + i * 8192, R, C); const int Rb = Epi::PERM ? ((R & ~31) + perm32(R & 31)) : R;
        voffA[i] = (unsigned)(R * LD + C) * 2u; voffB[i] = (unsigned)(Rb * LD + C) * 2u; }
    const size_t kstep = (size_t)(BK * 2);
    const size_t hstep = (size_t)HALF * LD * 2;
    const size_t tstep = 2 * hstep;
    const unsigned ldsw = (unsigned)wid * 1024u;
    const int aoff = lds_byte(wr * 64 + fr, fq * 8), boff = lds_byte(wc * 32 + fr, fq * 8);
#define PG8_SA(b, h) (((b) * 2 + (h)) * HTB)
#define PG8_SB(b, h) ((4 + (b) * 2 + (h)) * HTB)
#define PG8_STAGE(bufoff, gbase, voff) do { _Pragma("unroll") for (int _i = 0; _i < 2; ++_i) \
        __builtin_amdgcn_global_load_lds((const unsigned*)((const char*)(gbase) + (voff)[_i]), (PG8_LAS unsigned*)(lds + (bufoff) + ldsw + _i * 8192), 16, 0, 0); } while (0)
#define PG8_LDA(dst, b, h) do { _Pragma("unroll") for (int m = 0; m < 4; ++m) _Pragma("unroll") for (int k = 0; k < 2; ++k) dst[m][k] = *(const PG8_LAS bf16x8*)(lds + PG8_SA(b, h) + aoff + m * 2048 + k * 1024); } while (0)
#define PG8_LDB(dst, b, h) do { _Pragma("unroll") for (int n = 0; n < 2; ++n) _Pragma("unroll") for (int k = 0; k < 2; ++k) dst[n][k] = *(const PG8_LAS bf16x8*)(lds + PG8_SB(b, h) + boff + n * 2048 + k * 1024); } while (0)
#define PG8_MMA(ai, bj, At, Bt) do { __builtin_amdgcn_s_setprio(1); _Pragma("unroll") for (int m = 0; m < 4; ++m) _Pragma("unroll") for (int n = 0; n < 2; ++n) _Pragma("unroll") for (int k = 0; k < 2; ++k) \
        acc[ai][bj][m][n] = __builtin_amdgcn_mfma_f32_16x16x32_bf16(Bt[n][k], At[m][k], acc[ai][bj][m][n], 0, 0, 0); __builtin_amdgcn_s_setprio(0); } while (0)
#define PG8_WAIT_V(n) asm volatile("s_waitcnt vmcnt(" #n ")" ::: "memory")
#define PG8_WAIT_L(n) asm volatile("s_waitcnt lgkmcnt(" #n ")" ::: "memory")
#define PG8_BAR __builtin_amdgcn_s_barrier()
#define PG8_SCHED __builtin_amdgcn_sched_barrier(0)
    Unit cur, nxt; int ui = 0;
    if (!S.next(0, cur)) return;
    f32x4 acc[2][2][4][2];
#pragma unroll
    for (int a = 0; a < 2; ++a)
#pragma unroll
        for (int b = 0; b < 2; ++b)
#pragma unroll
            for (int m = 0; m < 4; ++m)
#pragma unroll
                for (int n = 0; n < 2; ++n) acc[a][b][m][n] = (f32x4){0.f, 0.f, 0.f, 0.f};
    bf16x8 At[4][2], B0[2][2], B1[2][2];
        const char* cA = (const char*)g.A + (size_t)cur.pm * tstep + (size_t)cur.ks * g.ksA; const char* cB = (const char*)g.Bt + (size_t)cur.pn * tstep + (size_t)cur.ks * g.ksB;
    S.a_ready(cur);
    if constexpr (SP2) {
        PG8_STAGE(PG8_SB(0, 0), cB, voffB); PG8_STAGE(PG8_SB(0, 1), cB + hstep, voffB); PG8_STAGE(PG8_SA(0, 0), cA, voffA); PG8_STAGE(PG8_SA(0, 1), cA + hstep, voffA);
        if (wr == 1) PG8_BAR;
        PG8_WAIT_V(2); PG8_BAR;
        PG8_STAGE(PG8_SB(1, 0), cB + kstep, voffB); PG8_STAGE(PG8_SA(1, 0), cA + kstep, voffA); PG8_STAGE(PG8_SB(1, 1), cB + hstep + kstep, voffB);
        PG8_WAIT_V(6); PG8_BAR;
    } else {
        PG8_STAGE(PG8_SB(0, 0), cB, voffB); PG8_STAGE(PG8_SA(0, 0), cA, voffA); PG8_STAGE(PG8_SB(0, 1), cB + hstep, voffB); PG8_STAGE(PG8_SA(0, 1), cA + hstep, voffA);
        if (wr == 1) PG8_BAR;
        PG8_WAIT_V(4); PG8_BAR;
        PG8_STAGE(PG8_SB(1, 0), cB + kstep, voffB); PG8_STAGE(PG8_SA(1, 0), cA + kstep, voffA); PG8_STAGE(PG8_SB(1, 1), cB + hstep + kstep, voffB);
        PG8_WAIT_V(6); PG8_BAR;
    }
    for (;;) {
        const bool has_next = S.next(ui + 1, nxt);
        const char* nA = has_next ? (const char*)g.A + (size_t)nxt.pm * tstep + (size_t)nxt.ks * g.ksA : cA; const char* nB = has_next ? (const char*)g.Bt + (size_t)nxt.pn * tstep + (size_t)nxt.ks * g.ksB : cB;
        for (int t = 0; t < nt; t += 2) {
            const bool last = (t == nt - 2);
            const char* a1 = cA + (size_t)(t + 1) * kstep;
            const char* a2 = last ? nA : cA + (size_t)(t + 2) * kstep; const char* b2 = last ? nB : cB + (size_t)(t + 2) * kstep;
            const char* a3 = a2 + kstep; const char* b3 = b2 + kstep;
            if (last && has_next) S.a_ready(nxt);
            if constexpr (SP2) {
            PG8_LDB(B0, 0, 0); PG8_LDB(B1, 0, 1); PG8_SCHED; PG8_LDA(At, 0, 0); PG8_STAGE(PG8_SA(1, 1), a1 + hstep, voffA);
            PG8_WAIT_V(8); PG8_WAIT_L(0); PG8_BAR; PG8_MMA(0, 0, At, B0); PG8_MMA(0, 1, At, B1); PG8_BAR; PG8_SCHED;
            PG8_LDA(At, 0, 1); PG8_STAGE(PG8_SB(0, 0), b2, voffB); PG8_STAGE(PG8_SB(0, 1), b2 + hstep, voffB); PG8_STAGE(PG8_SA(0, 0), a2, voffA);
            PG8_WAIT_V(8); PG8_WAIT_L(0); PG8_BAR; PG8_MMA(1, 0, At, B0); PG8_MMA(1, 1, At, B1); PG8_BAR; PG8_SCHED;
            PG8_LDB(B0, 1, 0); PG8_LDB(B1, 1, 1); PG8_SCHED; PG8_LDA(At, 1, 0); PG8_STAGE(PG8_SA(0, 1), a2 + hstep, voffA);
            PG8_WAIT_V(8); PG8_WAIT_L(0); PG8_BAR; PG8_MMA(0, 0, At, B0); PG8_MMA(0, 1, At, B1); PG8_BAR; PG8_SCHED;
            PG8_LDA(At, 1, 1); PG8_STAGE(PG8_SB(1, 0), b3, voffB); PG8_STAGE(PG8_SB(1, 1), b3 + hstep, voffB); PG8_STAGE(PG8_SA(1, 0), a3, voffA);
            PG8_WAIT_V(8); PG8_WAIT_L(0); PG8_BAR; PG8_MMA(1, 0, At, B0); PG8_MMA(1, 1, At, B1); PG8_BAR; PG8_SCHED;
            } else {
            PG8_LDB(B0, 0, 0); PG8_SCHED; PG8_LDA(At, 0, 0); PG8_STAGE(PG8_SA(1, 1), a1 + hstep, voffA);
            PG8_WAIT_L(8); PG8_BAR; PG8_WAIT_L(0); PG8_MMA(0, 0, At, B0); PG8_BAR; PG8_SCHED;
            PG8_LDB(B1, 0, 1); PG8_STAGE(PG8_SB(0, 0), b2, voffB);
            PG8_BAR; PG8_WAIT_L(0); PG8_MMA(0, 1, At, B1); PG8_BAR;
            PG8_LDA(At, 0, 1); PG8_STAGE(PG8_SA(0, 0), a2, voffA);
            PG8_BAR; PG8_WAIT_L(0); PG8_MMA(1, 0, At, B0); PG8_BAR; PG8_SCHED;
            PG8_STAGE(PG8_SB(0, 1), b2 + hstep, voffB);
            PG8_WAIT_V(6); PG8_BAR; PG8_MMA(1, 1, At, B1); PG8_BAR;
            PG8_LDB(B0, 1, 0); PG8_SCHED; PG8_LDA(At, 1, 0); PG8_STAGE(PG8_SA(0, 1), a2 + hstep, voffA);
            PG8_WAIT_L(8); PG8_BAR; PG8_WAIT_L(0); PG8_MMA(0, 0, At, B0); PG8_BAR; PG8_SCHED;
            PG8_LDB(B1, 1, 1); PG8_STAGE(PG8_SB(1, 0), b3, voffB);
            PG8_BAR; PG8_WAIT_L(0); PG8_MMA(0, 1, At, B1); PG8_BAR;
            PG8_LDA(At, 1, 1); PG8_STAGE(PG8_SA(1, 0), a3, voffA);
            PG8_BAR; PG8_WAIT_L(0); PG8_MMA(1, 0, At, B0); PG8_BAR; PG8_SCHED;
            PG8_STAGE(PG8_SB(1, 1), b3 + hstep, voffB);
            PG8_WAIT_V(6); PG8_BAR; PG8_MMA(1, 1, At, B1); PG8_BAR;
            }
        }
        if constexpr (ALIGN_EPI) { if (wr == 0) PG8_BAR; }
        if constexpr (!Epi::AFTER_DRAIN) { E(acc, cur, wr, wc, fr, fq); S.done(cur); }
        if (!has_next) break;
#pragma unroll
        for (int a = 0; a < 2; ++a)
#pragma unroll
            for (int b = 0; b < 2; ++b)
#pragma unroll
                for (int m = 0; m < 4; ++m)
#pragma unroll
                    for (int n = 0; n < 2; ++n) acc[a][b][m][n] = (f32x4){0.f, 0.f, 0.f, 0.f};
        cur = nxt; cA = nA; cB = nB; ++ui;
        if constexpr (ALIGN_EPI) { if (wr == 1) PG8_BAR; }
    }
    PG8_WAIT_V(0);
    if constexpr (!ALIGN_EPI) { if (wr == 0) PG8_BAR; }
    PG8_BAR;
    if constexpr (Epi::AFTER_DRAIN) { E.fused(acc, cur, wr, wc, fr, fq, lds, wid, lane); S.done(cur); }
#undef PG8_SA
#undef PG8_SB
#undef PG8_STAGE
#undef PG8_LDA
#undef PG8_LDB
#undef PG8_MMA
#undef PG8_WAIT_V
#undef PG8_WAIT_L
#undef PG8_BAR
#undef PG8_SCHED
}
}

namespace att {
typedef unsigned short bf16;
using bf16x8 = __attribute__((ext_vector_type(8))) short;
using s16x4  = __attribute__((ext_vector_type(4))) short;
using f32x16 = __attribute__((ext_vector_type(16))) float;
using u32x4  = __attribute__((ext_vector_type(4))) unsigned;
constexpr int   D = 128, NW = 8, QBLK = 32, KVBLK = 64, LDQ = 1024, LDK = 256, LDO = 1024;
constexpr float SCALE = 0.088388347648318440f, THR = 8.f;
constexpr size_t SHM_V = KVBLK * D * 2, SHM_K = KVBLK * D * 2, SHM_ATTN = 2 * SHM_V + 2 * SHM_K + NW * 64 * 4;
#define KSWZ(row, colB) ((row) * 256 + ((colB) ^ (((row) & 7) << 4)))
#define SBAR() __builtin_amdgcn_sched_barrier(0)
__device__ __forceinline__ int crow(int r, int hi) { return (r & 3) + 8 * (r >> 2) + 4 * hi; }
__device__ __forceinline__ unsigned cvtpk(float lo, float hi) { unsigned r; asm volatile("v_cvt_pk_bf16_f32 %0, %1, %2" : "=v"(r) : "v"(lo), "v"(hi)); return r; }

__device__ __forceinline__ void partialSM(f32x16& p0, f32x16& p1, float& m_reg, float& mn, float& alpha) {
  constexpr float C = SCALE * 1.4426950408889634f;
  float pmax = p0[0];
#pragma unroll
  for (int r = 1; r < 16; ++r) pmax = fmaxf(pmax, p0[r]);
#pragma unroll
  for (int r = 0; r < 16; ++r) pmax = fmaxf(pmax, p1[r]);
  { auto rr = __builtin_amdgcn_permlane32_swap(__float_as_uint(pmax), __float_as_uint(pmax), false, false);
    pmax = fmaxf(__uint_as_float(rr[0]), __uint_as_float(rr[1])); }
  if (__builtin_expect(__all(pmax - m_reg <= THR / SCALE), 1)) { mn = m_reg; alpha = 1.f; }
  else { mn = fmaxf(m_reg, pmax); alpha = __builtin_amdgcn_exp2f((m_reg - mn) * C); m_reg = mn; }
  float mnC = -mn * C;
#pragma unroll
  for (int r = 0; r < 16; ++r) p0[r] = fmaf(p0[r], C, mnC);
#pragma unroll
  for (int r = 0; r < 16; ++r) p1[r] = fmaf(p1[r], C, mnC);
#pragma unroll
  for (int r = 0; r < 16; ++r) p0[r] = __builtin_amdgcn_exp2f(p0[r]);
}
__device__ __forceinline__ void finishSM(f32x16& p0, f32x16& p1, float alpha, float& l_reg, bf16x8& pa0, bf16x8& pa1, bf16x8& pa2, bf16x8& pa3) {
#pragma unroll
  for (int r = 0; r < 16; ++r) p1[r] = __builtin_amdgcn_exp2f(p1[r]);
  float ps = 0;
#pragma unroll
  for (int r = 0; r < 16; ++r) ps += p0[r];
#pragma unroll
  for (int r = 0; r < 16; ++r) ps += p1[r];
  { auto rr = __builtin_amdgcn_permlane32_swap(__float_as_uint(ps), __float_as_uint(ps), false, false);
    ps = __uint_as_float(rr[0]) + __uint_as_float(rr[1]); }
  l_reg = l_reg * alpha + ps;
#define PK4(P, BASE, OUT) do { unsigned a0 = cvtpk(P[BASE + 0], P[BASE + 1]), a1 = cvtpk(P[BASE + 2], P[BASE + 3]);   \
    unsigned b0 = cvtpk(P[BASE + 4], P[BASE + 5]), b1 = cvtpk(P[BASE + 6], P[BASE + 7]);                              \
    auto r0 = __builtin_amdgcn_permlane32_swap(a0, b0, false, false); auto r1 = __builtin_amdgcn_permlane32_swap(a1, b1, false, false); \
    u32x4 w = {r0[0], r1[0], r0[1], r1[1]}; OUT = *reinterpret_cast<bf16x8*>(&w); } while (0)
  PK4(p0, 0, pa0); PK4(p0, 8, pa1); PK4(p1, 0, pa2); PK4(p1, 8, pa3);
#undef PK4
}
__device__ __forceinline__ void qkt(f32x16& p0, f32x16& p1, const bf16* Ks, const bf16x8* qr, int r32, int hi, bool domask, int mbase) {
  if (domask) {
#pragma unroll
    for (int r = 0; r < 16; ++r) { const int c = (r & 3) + 8 * (r >> 2);
      p0[r] = ((unsigned)(mbase + c + 128) <= 256u) ? 0.f : -INFINITY; p1[r] = ((unsigned)(mbase + c + 32 + 128) <= 256u) ? 0.f : -INFINITY; }
  } else { p0 = f32x16{}; p1 = f32x16{}; }
#pragma unroll
  for (int d0 = 0; d0 < 8; ++d0) { int cb = (d0 * 16 + hi * 8) * 2;
    bf16x8 b0 = *reinterpret_cast<const bf16x8*>((const char*)Ks + KSWZ(r32, cb));
    bf16x8 b1 = *reinterpret_cast<const bf16x8*>((const char*)Ks + KSWZ(32 + r32, cb));
    p0 = __builtin_amdgcn_mfma_f32_32x32x16_bf16(b0, qr[d0], p0, 0, 0, 0);
    p1 = __builtin_amdgcn_mfma_f32_32x32x16_bf16(b1, qr[d0], p1, 0, 0, 0); }
}
__device__ __forceinline__ int v_st(int k, int c) { const int kk = (k & ~0xC) | ((k & 4) << 1) | ((k & 8) >> 1); return ((kk >> 3) * 4 + (c >> 5)) * 512 + ((kk & 7) * 32 + (c & 31)) * 2; }
__device__ __forceinline__ int v_rd_base(int lane) { return ((lane & 3) << 3) | (((lane >> 2) & 3) << 6) | (((lane >> 4) & 1) << 5) | (((lane >> 5) & 1) << 8); }
constexpr int v_rd_off(int d0, int ks, int half) { return d0 * 512 + ks * 4096 + half * 2048; }
template <int OFF> __device__ __forceinline__ s16x4 tr_read(int vb) {
  s16x4 r; asm volatile("ds_read_b64_tr_b16 %0, %1 offset:%2" : "=&v"(r) : "v"(vb), "i"(OFF) : "memory"); return r;
}
template <int D0> __device__ __forceinline__ void pv_one(f32x16& od, int vb, bf16x8 pa0, bf16x8 pa1, bf16x8 pa2, bf16x8 pa3) {
  const s16x4 l0 = tr_read<v_rd_off(D0, 0, 0)>(vb), h0 = tr_read<v_rd_off(D0, 0, 1)>(vb), l1 = tr_read<v_rd_off(D0, 1, 0)>(vb), h1 = tr_read<v_rd_off(D0, 1, 1)>(vb);
  const s16x4 l2 = tr_read<v_rd_off(D0, 2, 0)>(vb), h2 = tr_read<v_rd_off(D0, 2, 1)>(vb), l3 = tr_read<v_rd_off(D0, 3, 0)>(vb), h3 = tr_read<v_rd_off(D0, 3, 1)>(vb);
  asm volatile("s_waitcnt lgkmcnt(0)" ::: "memory"); SBAR();
#define PK(L, H) (bf16x8){L[0], L[1], L[2], L[3], H[0], H[1], H[2], H[3]}
  od = __builtin_amdgcn_mfma_f32_32x32x16_bf16(pa0, PK(l0, h0), od, 0, 0, 0);
  od = __builtin_amdgcn_mfma_f32_32x32x16_bf16(pa1, PK(l1, h1), od, 0, 0, 0);
  od = __builtin_amdgcn_mfma_f32_32x32x16_bf16(pa2, PK(l2, h2), od, 0, 0, 0);
  od = __builtin_amdgcn_mfma_f32_32x32x16_bf16(pa3, PK(l3, h3), od, 0, 0, 0);
#undef PK
}
__device__ __forceinline__ void pv_d0(f32x16* o, int vb, bf16x8 pa0, bf16x8 pa1, bf16x8 pa2, bf16x8 pa3) {
  pv_one<0>(o[0], vb, pa0, pa1, pa2, pa3); pv_one<1>(o[1], vb, pa0, pa1, pa2, pa3); pv_one<2>(o[2], vb, pa0, pa1, pa2, pa3); pv_one<3>(o[3], vb, pa0, pa1, pa2, pa3);
}

__device__ __forceinline__ void attn_body(const bf16* __restrict__ Qb, const bf16* __restrict__ Kl, const bf16* __restrict__ Vl, const bf16* __restrict__ Kc, const bf16* __restrict__ Vc,
                                          int NT, int nloc, bool masked, int kp0, int q0, float sink_l2, bf16* __restrict__ Ob, char* lds, int tid) {
  const int wid = tid >> 6, lane = tid & 63, r32 = lane & 31, hi = lane >> 5;
  bf16* V_lds = (bf16*)lds; bf16* K_lds = (bf16*)(lds + 2 * SHM_V);
  float* wsl = (float*)(lds + 2 * SHM_V + 2 * SHM_K) + wid * 64; float* li_l = wsl; float* al_l = wsl + 32;
  float m_reg = -1e30f, l_reg = 0; f32x16 o[4] = {}; bf16x8 qr[8];
  const bf16* Qw = Qb + (long)(wid * QBLK + r32) * LDQ + hi * 8;
#pragma unroll
  for (int d0 = 0; d0 < 8; ++d0) qr[d0] = *reinterpret_cast<const bf16x8*>(Qw + d0 * 16);
  const int sr = tid >> 4, sc = (tid & 15) * 8, vst0 = v_st(sr, sc), vst1 = v_st(32 + sr, sc);
  const int vb0 = (int)(uintptr_t)V_lds + v_rd_base(lane);
  const int mb0 = kp0 - (q0 + wid * QBLK + r32) + 4 * hi;
  struct { bf16x8 vs0, vs1, ks0, ks1; } sr_[2];
#define TILEK(j) ((j) < nloc ? Kl + (long)(j) * (KVBLK * LDK) : Kc + (long)((j) - nloc) * (KVBLK * LDK))
#define TILEV(j) ((j) < nloc ? Vl + (long)(j) * (KVBLK * LDK) : Vc + (long)((j) - nloc) * (KVBLK * LDK))
#define SLOAD(i, j) do { const bf16* kt_ = TILEK(j); const bf16* vt_ = TILEV(j); \
    sr_[i].vs0 = *reinterpret_cast<const bf16x8*>(&vt_[(long)(sr) * LDK + sc]); sr_[i].vs1 = *reinterpret_cast<const bf16x8*>(&vt_[(long)(32 + sr) * LDK + sc]); \
    sr_[i].ks0 = *reinterpret_cast<const bf16x8*>(&kt_[(long)(sr) * LDK + sc]); sr_[i].ks1 = *reinterpret_cast<const bf16x8*>(&kt_[(long)(32 + sr) * LDK + sc]); } while (0)
#define SWRITE(b, i) do { *(bf16x8*)((char*)V_lds + (b) * SHM_V + vst0) = sr_[i].vs0;          \
    *(bf16x8*)((char*)V_lds + (b) * SHM_V + vst1) = sr_[i].vs1; int kc = sc * 2;               \
    *(bf16x8*)((char*)K_lds + (b) * SHM_K + KSWZ(sr, kc)) = sr_[i].ks0;                       \
    *(bf16x8*)((char*)K_lds + (b) * SHM_K + KSWZ(32 + sr, kc)) = sr_[i].ks1; } while (0)
#define SWAIT() asm volatile("s_waitcnt vmcnt(4)" ::: "memory")
#define RESC(a) do { if (__any((a) < 1.f)) { if (hi == 0) al_l[r32] = (a); asm volatile("s_waitcnt lgkmcnt(0)" ::: "memory"); \
    _Pragma("unroll") for (int d = 0; d < 4; ++d) _Pragma("unroll") for (int r = 0; r < 16; ++r) o[d][r] *= al_l[crow(r, hi)]; } } while (0)
#define QKT(P0, P1, KS, j) qkt(P0, P1, KS, qr, r32, hi, masked && (j) < nloc, mb0 + 64 * (j))
  f32x16 pA0, pA1, pB0, pB1; float mnA, mnB, alA, alB; bf16x8 pa0, pa1, pa2, pa3;
  constexpr int SE = 0, SO = 1;
  SLOAD(SE, 0); asm volatile("s_waitcnt vmcnt(0)" ::: "memory"); SWRITE(0, SE); __syncthreads();
  QKT(pA0, pA1, K_lds, 0); partialSM(pA0, pA1, m_reg, mnA, alA);
  SLOAD(SO, 1); if (2 < NT) SLOAD(SE, 2);
  SWAIT(); SWRITE(1, SO); __syncthreads();
  for (int j = 1; j + 1 < NT; j += 2) {
    SBAR(); QKT(pB0, pB1, (bf16*)((char*)K_lds + SHM_K), j);
    finishSM(pA0, pA1, alA, l_reg, pa0, pa1, pa2, pa3); SBAR();
    SLOAD(SO, (j + 2 < NT ? j + 2 : NT - 1)); SBAR();
    pv_d0(o, vb0, pa0, pa1, pa2, pa3); partialSM(pB0, pB1, m_reg, mnB, alB);
    __syncthreads(); SWAIT(); SWRITE(0, SE);
    RESC(alB); __syncthreads();
    SBAR(); QKT(pA0, pA1, K_lds, j + 1);
    finishSM(pB0, pB1, alB, l_reg, pa0, pa1, pa2, pa3); SBAR();
    if (j + 3 < NT) SLOAD(SE, j + 3); SBAR();
    pv_d0(o, vb0 + (int)SHM_V, pa0, pa1, pa2, pa3); partialSM(pA0, pA1, m_reg, mnA, alA);
    __syncthreads(); SWAIT(); SWRITE(1, SO);
    RESC(alA); __syncthreads();
  }
  SBAR(); QKT(pB0, pB1, (bf16*)((char*)K_lds + SHM_K), NT - 1);
  finishSM(pA0, pA1, alA, l_reg, pa0, pa1, pa2, pa3); SBAR();
  pv_d0(o, vb0, pa0, pa1, pa2, pa3); partialSM(pB0, pB1, m_reg, mnB, alB);
  __syncthreads(); RESC(alB);
  finishSM(pB0, pB1, alB, l_reg, pa0, pa1, pa2, pa3); SBAR();
  pv_d0(o, vb0 + (int)SHM_V, pa0, pa1, pa2, pa3);
  l_reg += __builtin_amdgcn_exp2f(sink_l2 - m_reg * (SCALE * 1.4426950408889634f));
  if (hi == 0) li_l[r32] = l_reg; asm volatile("s_waitcnt lgkmcnt(0)" ::: "memory");
  float rli[16];
#pragma unroll
  for (int r = 0; r < 16; ++r) rli[r] = __builtin_amdgcn_rcpf(li_l[crow(r, hi)]);
  bf16* Ow = Ob + (long)(wid * QBLK) * LDO;
#pragma unroll
  for (int r = 0; r < 16; ++r) { int orow = crow(r, hi);
#pragma unroll
    for (int d0 = 0; d0 < 4; ++d0) { const float ov = o[d0][r] * rli[r]; Ow[(long)orow * LDO + d0 * 32 + r32] = (bf16)cvtpk(ov, ov); } }
  __syncthreads();
#undef TILEK
#undef TILEV
#undef SLOAD
#undef SWRITE
#undef SWAIT
#undef RESC
#undef QKT
}
#undef KSWZ
#undef SBAR
}

constexpr int DM = 2048, NPR = 8192, NSR = 2048, MT = 10240, IN_DIM = 6656, DFF = 8192;
constexpr float LN_EPS = 1e-5f, RMS_EPS = 1e-6f, DN_ALPHA = 1.681792830507429f, ATT_SCALE = 0.08838834764831845f;
constexpr size_t OUT_CK = 20971520, OUT_CV = 29360128, OUT_SF = 37748736, OUT_SB = 54525952;
constexpr size_t MiB = 1u << 20;
constexpr size_t WS_CTL = 0, CTL_ZERO_BYTES = 1 * MiB;
constexpr size_t WS_ROPE = 1 * MiB, WS_LB = 1 * MiB + 65536, WS_MODS = 2 * MiB;
constexpr size_t WS_WIN = 4 * MiB, WS_WO = 108 * MiB, WS_WUP = 140 * MiB, WS_WDN = 268 * MiB;
constexpr size_t WS_X = 396 * MiB, WS_Y = 476 * MiB, WS_H = 556 * MiB, WS_MIX = 596 * MiB, WS_ACT = 636 * MiB;
constexpr size_t WS_QB = 796 * MiB, WS_KB = 816 * MiB, WS_VB = 821 * MiB, WS_HQ = 826 * MiB, WS_HI = 846 * MiB, WS_HG = 866 * MiB;
constexpr size_t WS_ZF = 886 * MiB, WS_ZB = 926 * MiB, WS_OF = 966 * MiB, WS_OB = 1006 * MiB, WS_ATT = 1046 * MiB, WS_CKB = 1086 * MiB, WS_CVB = 1088 * MiB, WS_SL = 1090 * MiB, WS_END = 1250 * MiB;
constexpr int CW_BAR = 4096, CW_Q = 16384;
constexpr int RING_BYTES = 131072, LDS_BYTES = 163840, LDSCTL_OFF = LDS_BYTES - 512, MISC_OFF = LDSCTL_OFF + 320;

#define GAS __attribute__((address_space(1)))
#define LAS __attribute__((address_space(3)))
typedef unsigned short bf16;
typedef unsigned v4u __attribute__((ext_vector_type(4)));
typedef unsigned v2u __attribute__((ext_vector_type(2)));
typedef float f32x4 __attribute__((ext_vector_type(4)));
typedef float f32x2 __attribute__((ext_vector_type(2)));
typedef GAS unsigned gu32;
#define LDS_WAIT() asm volatile("s_waitcnt lgkmcnt(0)" ::: "memory")
typedef float f32x2_t __attribute__((ext_vector_type(2))); typedef __bf16 bf16x2_t __attribute__((ext_vector_type(2)));
__device__ __forceinline__ unsigned pk2(float lo, float hi) { f32x2_t v = {lo, hi}; bf16x2_t b = __builtin_convertvector(v, bf16x2_t); return __builtin_bit_cast(unsigned, b); }
__device__ __forceinline__ unsigned f2bf(float f) { return pk2(f, f) & 0xffffu; }
__device__ __forceinline__ float bflo(unsigned w) { return __builtin_bit_cast(float, w << 16); }
__device__ __forceinline__ float bfhi(unsigned w) { return __builtin_bit_cast(float, w & 0xffff0000u); }
__device__ __forceinline__ float bf2f(bf16 b) { return __builtin_bit_cast(float, ((unsigned)b) << 16); }
__device__ __forceinline__ float siluf(float x) { return x * __builtin_amdgcn_rcpf(1.f + __expf(-x)); }


namespace hg {
typedef unsigned short bf16;
using bf16x8 = __attribute__((ext_vector_type(8))) short;
using bf16x4 = __attribute__((ext_vector_type(4))) short;
using f32x16 = __attribute__((ext_vector_type(16))) float;
constexpr int QS = 136, TS = 40;
constexpr int OFF_QT = 0, OFF_KT = 8704, OFF_KTT = 17408, OFF_EMID = 27648, OFF_ELM = 28160, OFF_VT = 28672, VT_BYTES = 2560, BUF_BYTES = 38912;
constexpr int HG_LDS_BYTES = 4 * BUF_BYTES;
__device__ __forceinline__ int crow(int r, int hi) { return (r & 3) + 8 * (r >> 2) + 4 * hi; }
__device__ __forceinline__ unsigned cvtpk(float lo, float hi) { return ::pk2(lo, hi); }
__device__ __forceinline__ unsigned f2bfc(float f) { unsigned u = __builtin_bit_cast(unsigned, f); return (u + 0x7fffu + ((u >> 16) & 1u)) >> 16; }
__device__ __forceinline__ unsigned pk2c(float lo, float hi) { return ::pk2(lo, hi); }
__device__ __forceinline__ bf16x8 pack8(const f32x16& x, int b) {
  typedef unsigned u32x4 __attribute__((ext_vector_type(4)));
  u32x4 w = {cvtpk(x[b + 0], x[b + 1]), cvtpk(x[b + 2], x[b + 3]), cvtpk(x[b + 4], x[b + 5]), cvtpk(x[b + 6], x[b + 7])}; return __builtin_bit_cast(bf16x8, w);
}
__device__ __forceinline__ bf16x8 cat4(bf16x4 a, bf16x4 b) { return (bf16x8){a[0], a[1], a[2], a[3], b[0], b[1], b[2], b[3]}; }

__device__ __forceinline__ void gates_to_lds(LAS unsigned char* buf, const float (&zr)[16], const bf16 (&qr)[16], bf16x8 va, bf16x8 vb, float lbv, float olb, int dkg, int half, int js, int r32, int hi) {
  LAS bf16* Qt = (LAS bf16*)(buf + OFF_QT); LAS bf16* Kt = (LAS bf16*)(buf + OFF_KT); LAS bf16* KtT = (LAS bf16*)(buf + OFF_KTT);
  LAS float* emid = (LAS float*)(buf + OFF_EMID); LAS float* elm = (LAS float*)(buf + OFF_ELM); LAS bf16* Vt = (LAS bf16*)(buf + OFF_VT + js * VT_BYTES);
  float fz[16], kz[16], qt[16], kt[16];
#pragma unroll
  for (int ii = 0; ii < 16; ++ii) { const float rr = __builtin_amdgcn_rcpf(1.f + __expf(-zr[ii]));
    fz[ii] = fmaf(olb, rr, lbv); kz[ii] = fmaf(-olb, rr, olb); qt[ii] = __builtin_bit_cast(float, ((unsigned)qr[ii]) << 16); }
  if (half) { float E = 1.f;
#pragma unroll
    for (int ii = 0; ii < 16; ++ii) { E = fmaxf(E * fz[ii], 1e-30f); qt[ii] *= E; kt[ii] = kz[ii] * __builtin_amdgcn_rcpf(E); }
    elm[dkg] = E;
  } else { float Dd = 1.f;
#pragma unroll
    for (int ii = 15; ii >= 0; --ii) { qt[ii] *= __builtin_amdgcn_rcpf(Dd); kt[ii] = kz[ii] * Dd; Dd = fmaxf(Dd * fz[ii], 1e-30f); }
    emid[dkg] = Dd;
  }
  unsigned kw[8];
#pragma unroll
  for (int m = 0; m < 8; ++m) { const unsigned qw = cvtpk(qt[2 * m], qt[2 * m + 1]); kw[m] = cvtpk(kt[2 * m], kt[2 * m + 1]); const int i0 = 16 * half + 2 * m;
    Qt[i0 * QS + dkg] = (bf16)qw; Qt[(i0 + 1) * QS + dkg] = (bf16)(qw >> 16); Kt[i0 * QS + dkg] = (bf16)kw[m]; Kt[(i0 + 1) * QS + dkg] = (bf16)(kw[m] >> 16); }
  typedef unsigned u32x4 __attribute__((ext_vector_type(4)));
  LAS u32x4* kd = (LAS u32x4*)(KtT + dkg * TS + 16 * half);
  kd[0] = (u32x4){kw[0], kw[1], kw[2], kw[3]}; kd[1] = (u32x4){kw[4], kw[5], kw[6], kw[7]};
#pragma unroll
  for (int e = 0; e < 8; ++e) { Vt[(16 * hi + e) * TS + r32] = (bf16)va[e]; Vt[(16 * hi + 8 + e) * TS + r32] = (bf16)vb[e]; }
}

__device__ __forceinline__ f32x16 chunk_mfma(LAS unsigned char* buf, f32x16 (&S)[4], int js, int r32, int hi) {
  const LAS bf16* Qt = (const LAS bf16*)(buf + OFF_QT); const LAS bf16* Kt = (const LAS bf16*)(buf + OFF_KT); const LAS bf16* KtT = (const LAS bf16*)(buf + OFF_KTT);
  const LAS float* emid = (const LAS float*)(buf + OFF_EMID); const LAS float* elm = (const LAS float*)(buf + OFF_ELM); const LAS bf16* Vt = (const LAS bf16*)(buf + OFF_VT + js * VT_BYTES);
  bf16x8 Sb[4][2];
#pragma unroll
  for (int Tt = 0; Tt < 4; ++Tt) {
#pragma unroll
    for (int qd = 0; qd < 4; ++qd) { const f32x4 em = *(const LAS f32x4*)(emid + 32 * Tt + 8 * qd + 4 * hi);
#pragma unroll
      for (int e = 0; e < 4; ++e) S[Tt][4 * qd + e] *= em[e]; }
    Sb[Tt][0] = pack8(S[Tt], 0); Sb[Tt][1] = pack8(S[Tt], 8); }
  f32x16 AT = {}, oT = {};
#pragma unroll
  for (int hb = 0; hb < 2; ++hb) { bf16x8 ka[4], qb[4], qp[2][2];
#pragma unroll
    for (int st = 0; st < 4; ++st) { ka[st] = *(const LAS bf16x8*)(Kt + r32 * QS + 16 * (4 * hb + st) + 8 * hi); qb[st] = *(const LAS bf16x8*)(Qt + r32 * QS + 16 * (4 * hb + st) + 8 * hi); }
#pragma unroll
    for (int t2 = 0; t2 < 2; ++t2)
#pragma unroll
      for (int s2 = 0; s2 < 2; ++s2) { const LAS bf16* qr = Qt + r32 * QS + 32 * (2 * hb + t2) + 16 * s2 + 4 * hi; qp[t2][s2] = cat4(*(const LAS bf16x4*)(qr), *(const LAS bf16x4*)(qr + 8)); }
#pragma unroll
    for (int j = 0; j < 4; ++j) { AT = __builtin_amdgcn_mfma_f32_32x32x16_bf16(ka[j], qb[j], AT, 0, 0, 0);
      oT = __builtin_amdgcn_mfma_f32_32x32x16_bf16(Sb[2 * hb + (j >> 1)][j & 1], qp[j >> 1][j & 1], oT, 0, 0, 0); } }
  { const bf16x8 v0 = *(const LAS bf16x8*)(Vt + r32 * TS + 8 * hi), v1 = *(const LAS bf16x8*)(Vt + r32 * TS + 16 + 8 * hi);
    bf16x8 kf[4][2];
#pragma unroll
    for (int Tt = 0; Tt < 4; ++Tt) { const LAS bf16* kr = KtT + (32 * Tt + r32) * TS + 8 * hi; kf[Tt][0] = *(const LAS bf16x8*)(kr); kf[Tt][1] = *(const LAS bf16x8*)(kr + 16); }
#pragma unroll
    for (int Tt = 0; Tt < 4; ++Tt) S[Tt] = __builtin_amdgcn_mfma_f32_32x32x16_bf16(kf[Tt][0], v0, S[Tt], 0, 0, 0);
#pragma unroll
    for (int Tt = 0; Tt < 4; ++Tt) S[Tt] = __builtin_amdgcn_mfma_f32_32x32x16_bf16(kf[Tt][1], v1, S[Tt], 0, 0, 0); }
#pragma unroll
  for (int r = 0; r < 16; ++r) AT[r] = (crow(r, hi) <= r32) ? AT[r] : 0.f;
  { const bf16x8 Pb0 = pack8(AT, 0), Pb1 = pack8(AT, 8); const LAS bf16* vr = Vt + r32 * TS + 4 * hi;
    const bf16x8 v0 = cat4(*(const LAS bf16x4*)(vr), *(const LAS bf16x4*)(vr + 8)), v1 = cat4(*(const LAS bf16x4*)(vr + 16), *(const LAS bf16x4*)(vr + 24));
    oT = __builtin_amdgcn_mfma_f32_32x32x16_bf16(v0, Pb0, oT, 0, 0, 0);
    oT = __builtin_amdgcn_mfma_f32_32x32x16_bf16(v1, Pb1, oT, 0, 0, 0); }
#pragma unroll
  for (int Tt = 0; Tt < 4; ++Tt)
#pragma unroll
    for (int qd = 0; qd < 4; ++qd) { const f32x4 el = *(const LAS f32x4*)(elm + 32 * Tt + 8 * qd + 4 * hi);
#pragma unroll
      for (int e = 0; e < 4; ++e) S[Tt][4 * qd + e] *= el[e]; }
  return oT;
}

__device__ __forceinline__ void hgrn_body(LAS unsigned char* base, int tid, int wave, const float* __restrict__ Z, const bf16* __restrict__ HQ, const bf16* __restrict__ HI,
                                          bf16* __restrict__ O, const float* __restrict__ lb, const float* __restrict__ s_in, float* __restrict__ s_out, int row0, int T, int hcol, int dir) {
  const int lane = tid & 63, role = wave >> 2, js = wave & 3, r32 = lane & 31, hi = lane >> 5;
  const int nch = T >> 5;
#define HG_BAR() asm volatile("s_waitcnt lgkmcnt(0)\n\ts_barrier" ::: "memory")
  if (role) {
    const int lt = tid & 255, dkg = lt & 127, half = (wave >> 1) & 1;
    const float lbv = lb[dkg], olb = 1.f - lbv;
    float zr[16]; bf16 qr[16]; bf16x8 va, vb;
#define HG_LOAD(nn) do { _Pragma("unroll") for (int ii = 0; ii < 16; ++ii) { const int i_ = 32 * (nn) + 16 * half + ii, t_ = dir ? T - 1 - i_ : i_; const size_t off_ = (size_t)(row0 + t_) * 1024 + hcol + dkg; \
      zr[ii] = Z[off_]; qr[ii] = HQ[off_]; } \
    { const int i_ = 32 * (nn) + r32, t_ = dir ? T - 1 - i_ : i_; const bf16* src_ = HI + (size_t)(row0 + t_) * 1024 + hcol + 32 * js + 16 * hi; va = *(const bf16x8*)src_; vb = *(const bf16x8*)(src_ + 8); } } while (0)
    HG_LOAD(0);
    gates_to_lds(base, zr, qr, va, vb, lbv, olb, dkg, half, js, r32, hi);
    HG_LOAD(nch > 1 ? 1 : 0);
    HG_BAR();
    for (int n = 0; n < nch; ++n) {
      if (n + 1 < nch) gates_to_lds(base + ((n + 1) & 1) * BUF_BYTES, zr, qr, va, vb, lbv, olb, dkg, half, js, r32, hi);
      { const int nn = n + 2 < nch ? n + 2 : nch - 1; HG_LOAD(nn); }
      HG_BAR();
    }
#undef HG_LOAD
  } else {
    f32x16 S[4];
#pragma unroll
    for (int Tt = 0; Tt < 4; ++Tt)
#pragma unroll
      for (int r = 0; r < 16; ++r) S[Tt][r] = s_in ? s_in[(size_t)(32 * Tt + crow(r, hi)) * 128 + 32 * js + r32] : 0.f;
    HG_BAR();
    for (int n = 0; n < nch; ++n) {
      const f32x16 oT = chunk_mfma(base + (n & 1) * BUF_BYTES, S, js, r32, hi);
      { const int i = 32 * n + r32, t = dir ? T - 1 - i : i; bf16* op = O + (size_t)(row0 + t) * 1024 + hcol + 32 * js + 4 * hi; typedef unsigned u32x2_t __attribute__((ext_vector_type(2)));
#pragma unroll
        for (int qd = 0; qd < 4; ++qd) { u32x2_t w; w.x = pk2c(oT[4 * qd], oT[4 * qd + 1]); w.y = pk2c(oT[4 * qd + 2], oT[4 * qd + 3]);     *(u32x2_t*)(op + 8 * qd) = w; } }
      HG_BAR();
    }
    if (s_out) {
#pragma unroll
      for (int Tt = 0; Tt < 4; ++Tt)
#pragma unroll
        for (int r = 0; r < 16; ++r) s_out[(size_t)(32 * Tt + crow(r, hi)) * 128 + 32 * js + r32] = S[Tt][r];
    }
  }
#undef HG_BAR
}
}
#define XB_TMO      128
#define XB_XCNT(j)  (256  + 64 * (j))
#define XB_XSUB(j)  (1280 + 64 * (j))
#define XB_XGEN(j)  (2304 + 64 * (j))
#define XB_TOP      3328
#define XB_TOPGEN   3392
#define XCD_BAR_WORDS 3456
#define XB_SPIN_CAP (1u << 18)
__device__ __forceinline__ unsigned xb_ld(unsigned* p)              { return __hip_atomic_load(p, __ATOMIC_RELAXED, __HIP_MEMORY_SCOPE_AGENT); }
__device__ __forceinline__ unsigned xb_add(unsigned* p, unsigned v) { return __hip_atomic_fetch_add(p, v, __ATOMIC_RELAXED, __HIP_MEMORY_SCOPE_AGENT); }
__device__ __forceinline__ unsigned xb_xcc_id() { return (unsigned)__builtin_amdgcn_s_getreg((3 << 11) | 20) & 0xFu; }
#define XB_SPIN(cond, bar) do { unsigned _sp = 0; while (cond) { __builtin_amdgcn_s_sleep(1); \
    if ((++_sp & 255u) == 0u) { if (xb_ld(&(bar)[XB_TMO])) break; if (_sp > XB_SPIN_CAP) { atomicAdd(&(bar)[XB_TMO], 1u); break; } } } } while (0)
struct XcdBarrier { unsigned* bar; unsigned x; volatile LAS unsigned* st; };
__device__ __forceinline__ XcdBarrier xcd_barrier_post(unsigned* bar, volatile LAS unsigned* st) {
    XcdBarrier b; b.bar = bar; b.x = xb_xcc_id(); b.st = st;
    if (threadIdx.x == 0) (void)xb_add(&bar[XB_XCNT(b.x)], 1u);
    return b;
}
__device__ __forceinline__ void xcd_barrier_complete(unsigned* bar, unsigned x, unsigned& nloc, unsigned& nx) {
    const unsigned G = gridDim.x * gridDim.y * gridDim.z;
    unsigned sum, cnt, mine, sp = 0u;
    for (;;) {
        sum = 0u; cnt = 0u; mine = 0u;
#pragma unroll
        for (unsigned j = 0; j < 16; ++j) { const unsigned c = xb_ld(&bar[XB_XCNT(j)]); sum += c; cnt += (c > 0u) ? 1u : 0u; mine = (j == x) ? c : mine; }
        if (sum == G) break;
        __builtin_amdgcn_s_sleep(1);
        if ((++sp & 255u) == 0u) { if (xb_ld(&bar[XB_TMO])) break; if (sp > XB_SPIN_CAP) { atomicAdd(&bar[XB_TMO], 1u); break; } }
    }
    nloc = mine > 0u ? mine : 1u; nx = cnt > 0u ? cnt : 1u;
}
__device__ __forceinline__ void xcd_barrier(const XcdBarrier& b) {
    asm volatile("s_waitcnt vmcnt(0)" ::: "memory");
    __syncthreads();
    if (threadIdx.x == 0) {
        unsigned* bar = b.bar;
        __builtin_amdgcn_s_waitcnt(0);
        unsigned nloc = b.st[0], nx = b.st[1];
        if (nloc == 0u) { xcd_barrier_complete(bar, b.x, nloc, nx); b.st[0] = nloc; b.st[1] = nx; }
        const unsigned old = xb_add(&bar[XB_XSUB(b.x)], 1u);
        const unsigned gen = old / nloc;
        if (old + 1u == (gen + 1u) * nloc) {
            __builtin_amdgcn_fence(__ATOMIC_RELEASE, "agent");
            asm volatile("s_waitcnt vmcnt(0)" ::: "memory");
            const unsigned og = xb_add(&bar[XB_TOP], 1u);
            const unsigned tg = og / nx;
            if (og + 1u == (tg + 1u) * nx) xb_add(&bar[XB_TOPGEN], 1u);
            else XB_SPIN(xb_ld(&bar[XB_TOPGEN]) == tg, bar);
            __builtin_amdgcn_fence(__ATOMIC_ACQUIRE, "agent");
            xb_add(&bar[XB_XGEN(b.x)], 1u);
            asm volatile("s_waitcnt vmcnt(0)" ::: "memory");
        } else {
            XB_SPIN(xb_ld(&bar[XB_XGEN(b.x)]) == gen, bar);
            __builtin_amdgcn_fence(__ATOMIC_ACQUIRE, "agent");
            asm volatile("s_waitcnt vmcnt(0)" ::: "memory");
        }
    }
    __syncthreads();
}

struct Args { const float* in[20]; float* out; unsigned char* ws; };
typedef const __attribute__((address_space(4))) Args* KArgs;
#define GIN(i) ((const float*)(const GAS float*)(A->in[i]))
struct Frame { LAS unsigned char* lds; unsigned* ctl; unsigned char* ws; float* out; int tid, lane, wave, vcu, G; };

__device__ __forceinline__ float wave_sum(float v) {
#pragma unroll
    for (int o = 1; o < 64; o <<= 1) v += __shfl_xor(v, o);
    return v;
}
__device__ __forceinline__ float wave_max(float v) {
#pragma unroll
    for (int o = 1; o < 64; o <<= 1) v = fmaxf(v, __shfl_xor(v, o));
    return v;
}

__host__ __device__ __forceinline__ int rope_col(int d) { return (d & 64) | ((d & 31) << 1) | ((d >> 5) & 1); }
template <bool QKPERM>
__device__ __forceinline__ void p0_transpose_item(const float* W, int K, int N, bf16* WT, LAS float* scr, int item, int lane) {
    const int nblk = N / 32, kb = item / nblk, nb = item % nblk, k0 = 64 * kb, n0 = 32 * nb;
    float v[32];
#pragma unroll
    for (int i = 0; i < 32; ++i) { const int kk = 2 * i + (lane >> 5); v[i] = W[(size_t)(k0 + kk) * N + n0 + (lane & 31)]; }
#pragma unroll
    for (int i = 0; i < 32; ++i) { const int kk = 2 * i + (lane >> 5); scr[kk * 33 + (lane & 31)] = v[i]; }
    LDS_WAIT(); asm volatile("" ::: "memory");
    const int c = lane & 7;
#pragma unroll
    for (int j = 0; j < 4; ++j) { const int n = (lane >> 3) + 8 * j; const LAS float* s = scr + (8 * c) * 33 + n;
        v4u o; o.x = pk2(s[0 * 33], s[1 * 33]); o.y = pk2(s[2 * 33], s[3 * 33]); o.z = pk2(s[4 * 33], s[5 * 33]); o.w = pk2(s[6 * 33], s[7 * 33]);
        int nr = n0 + n; if (QKPERM && nr < 1280) nr = (nr & ~127) | rope_col(nr & 127);
        *(GAS v4u*)(WT + (size_t)nr * K + k0 + 8 * c) = o; }
    LDS_WAIT(); asm volatile("" ::: "memory");
}

__device__ __forceinline__ void mods_item(const Frame& F, KArgs A, const LAS float* sil, int mi) {
    const int l = mi / 96, cb = mi % 96; const int c4 = (F.lane & 31) * 4, kh = F.lane >> 5;
    const float* W = GIN(8) + (size_t)l * 2048 * 12288 + cb * 128 + c4;
    f32x4 a0 = {0.f, 0.f, 0.f, 0.f}, a1 = a0, a2 = a0;
    const float* Wp = W + (size_t)kh * 12288;
    for (int i0 = 0; i0 < 1024; i0 += 16) {
        f32x4 w[16];
#pragma unroll
        for (int j = 0; j < 16; ++j) w[j] = *(const f32x4*)(Wp + (size_t)(2 * j) * 12288);
        Wp += (size_t)32 * 12288;
#pragma unroll
        for (int j = 0; j < 16; ++j) { const int k = 2 * (i0 + j) + kh; a0 += sil[k] * w[j]; a1 += sil[2048 + k] * w[j]; a2 += sil[4096 + k] * w[j]; }
    }
#pragma unroll
    for (int e = 0; e < 4; ++e) { a0[e] += __shfl_xor(a0[e], 32); a1[e] += __shfl_xor(a1[e], 32); a2[e] += __shfl_xor(a2[e], 32); }
    if (F.lane < 32) {
        const f32x4 bias = *(const f32x4*)(GIN(9) + l * 12288 + cb * 128 + c4);
        float* M = (float*)(F.ws + WS_MODS) + (size_t)(l * 3) * 12288 + cb * 128 + c4;
        *(f32x4*)(M) = a0 + bias; *(f32x4*)(M + 12288) = a1 + bias; *(f32x4*)(M + 2 * 12288) = a2 + bias;
    }
}

__device__ __forceinline__ void p0_prologue(const Frame& F, KArgs A) {
    LAS float* sil = (LAS float*)(F.lds + 73728);
    for (int e = F.tid; e < 3 * 2048; e += 512) { const int j = e >> 11, k = e & 2047; const float c = (j == 0) ? GIN(7)[k] : GIN(6)[(j - 1) * 2048 + k]; sil[e] = c / (1.f + __expf(-c)); }
    __syncthreads();
    for (int mi = F.vcu + F.G * F.wave; mi < 384; mi += F.G * 8) mods_item(F, A, sil, mi);
    if (blockIdx.x == 0) {
        float* rope = (float*)(F.ws + WS_ROPE);
        for (int e = F.tid; e < 80 * 32; e += 512) { const int p = e >> 5, i = e & 31; const int pos = p < 16 ? p : p - 16;
            const float inv = exp2f(-(float)i * (13.287712379549449f / 32.f)); const float ang = (float)pos * inv;
            rope[2 * e] = cosf(ang); rope[2 * e + 1] = sinf(ang); }
        float* LB = (float*)(F.ws + WS_LB);
        for (int e = F.tid; e < 2048; e += 512) { const int dir = e >> 10, j = e & 1023; const float* lg = GIN(13) + (size_t)dir * 4096 + j;
            const float x0 = lg[0], x1 = lg[1024], x2 = lg[2048], x3 = lg[3072]; const float m = fmaxf(fmaxf(x0, x1), fmaxf(x2, x3));
            const float e0 = expf(x0 - m), e1 = expf(x1 - m), e2 = expf(x2 - m), e3 = expf(x3 - m); const float is = 1.f / (e0 + e1 + e2 + e3);
            float* o = LB + (size_t)dir * 4096 + j; o[0] = 0.f; o[1024] = e1 * is; o[2048] = (e1 + e2) * is; o[3072] = (e1 + e2 + e3) * is; }
    }
    {
        const int gt = F.vcu * 512 + F.tid, NGT = F.G * 512;
        for (int i = gt; i < 2 * 131072; i += NGT) { const bool isk = i < 131072; const int j = isk ? i : i - 131072; const float* src = (isk ? GIN(2) : GIN(3)) + (size_t)j * 8;
            const f32x4 x0 = *(const f32x4*)src, x1 = *(const f32x4*)(src + 4);
            if (isk) {
                bf16* dst = (bf16*)(F.ws + WS_CKB) + (((size_t)j * 8) & ~(size_t)127) + rope_col((j * 8) & 127);
                dst[0] = (bf16)f2bf(x0[0]); dst[2] = (bf16)f2bf(x0[1]); dst[4] = (bf16)f2bf(x0[2]); dst[6] = (bf16)f2bf(x0[3]);
                dst[8] = (bf16)f2bf(x1[0]); dst[10] = (bf16)f2bf(x1[1]); dst[12] = (bf16)f2bf(x1[2]); dst[14] = (bf16)f2bf(x1[3]);
            } else { v4u o; o.x = pk2(x0[0], x0[1]); o.y = pk2(x0[2], x0[3]); o.z = pk2(x1[0], x1[1]); o.w = pk2(x1[2], x1[3]); *(v4u*)((bf16*)(F.ws + WS_CVB) + (size_t)j * 8) = o; } }
    }
    LAS float* scr = (LAS float*)(F.lds + F.wave * 8704);
    const int gw = F.vcu * 8 + F.wave, NGW = F.G * 8;
    constexpr int I_IN = 32 * 208, I_O = 32 * 64, I_UP = 32 * 256, I_DN = 128 * 64, I_L = I_IN + I_O + I_UP + I_DN;
    for (int it = gw; it < 4 * I_L; it += NGW) {
        const int l = it / I_L; int r = it % I_L;
        if (r < I_IN) { p0_transpose_item<true>(GIN(10) + (size_t)l * 2048 * 6656, 2048, 6656, (bf16*)(F.ws + WS_WIN) + (size_t)l * 6656 * 2048, scr, r, F.lane); continue; } r -= I_IN;
        if (r < I_O) { p0_transpose_item<false>(GIN(15) + (size_t)l * 2048 * 2048, 2048, 2048, (bf16*)(F.ws + WS_WO) + (size_t)l * 2048 * 2048, scr, r, F.lane); continue; } r -= I_O;
        if (r < I_UP) { p0_transpose_item<false>(GIN(18) + (size_t)l * 2048 * 8192, 2048, 8192, (bf16*)(F.ws + WS_WUP) + (size_t)l * 8192 * 2048, scr, r, F.lane); continue; } r -= I_UP;
        p0_transpose_item<false>(GIN(19) + (size_t)l * 8192 * 2048, 8192, 2048, (bf16*)(F.ws + WS_WDN) + (size_t)l * 2048 * 8192, scr, r, F.lane);
    }
}

__device__ __forceinline__ int cond_of_row(int r) { return r < NPR ? 0 : 1 + ((r - NPR) >> 10); }

__device__ __forceinline__ void modulate0_phase(const Frame& F, KArgs A) {
    const int gw = F.vcu * 8 + F.wave, NGW = F.G * 8; const float* MODS = (const float*)(F.ws + WS_MODS); bf16* H = (bf16*)(F.ws + WS_H);
    for (int r = gw; r < MT; r += NGW) {
        const float* xr = r < NPR ? GIN(0) + (size_t)r * DM : GIN(1) + (size_t)(r - NPR) * DM; const float* md = MODS + (size_t)cond_of_row(r) * 12288;
#pragma unroll
        for (int j = 0; j < 8; ++j) { const int c = (F.lane + 64 * j) * 4; const f32x4 x = *(const f32x4*)(xr + c), sc = *(const f32x4*)(md + 2048 + c), sh = *(const f32x4*)(md + c);
            const f32x4 h = x * (1.f + sc) + sh; v2u o; o.x = pk2(h[0], h[1]); o.y = pk2(h[2], h[3]); *(v2u*)(H + (size_t)r * DM + c) = o; }
    }
}

__device__ __forceinline__ void ln_phase(const Frame& F, KArgs A, int l, int which, int r_begin, int r_end, int gw, int NGW) {
    const float* MODS = (const float*)(F.ws + WS_MODS); bf16* H = (bf16*)(F.ws + WS_H);
    const float* Y = (const float*)(F.ws + WS_Y); const bool last = (which == 1 && l == 3); float* X = last ? F.out : (float*)(F.ws + WS_X);
    const float* lg = GIN(16) + (size_t)(l * 2 + which) * DM; const float* lb = GIN(17) + (size_t)(l * 2 + which) * DM;
    for (int r = r_begin + gw; r < r_end; r += NGW) {
        const bool slabs = which == 1 && r >= NPR;
        const float* yr = (slabs ? (const float*)(F.ws + WS_X) : Y) + (size_t)r * DM; f32x4 v[8]; float s = 0.f;
#pragma unroll
        for (int j = 0; j < 8; ++j) { v[j] = *(const f32x4*)(yr + (F.lane + 64 * j) * 4);
            if (slabs) {
                v[j] = v[j] * DN_ALPHA;
                const bf16* sl = (const bf16*)(F.ws + WS_SL) + (size_t)r * DM + (F.lane + 64 * j) * 4;
#pragma unroll
                for (int k = 0; k < 4; ++k) { const v2u w = *(const v2u*)(sl + (size_t)k * MT * DM); v[j][0] += bflo(w.x); v[j][1] += bfhi(w.x); v[j][2] += bflo(w.y); v[j][3] += bfhi(w.y); } }
            s += (v[j][0] + v[j][1]) + (v[j][2] + v[j][3]); }
        const float mean = wave_sum(s) * (1.f / DM); float s2 = 0.f;
#pragma unroll
        for (int j = 0; j < 8; ++j) { v[j] = v[j] - mean; s2 += (v[j][0] * v[j][0] + v[j][1] * v[j][1]) + (v[j][2] * v[j][2] + v[j][3] * v[j][3]); }
        const float rstd = 1.f / sqrtf(wave_sum(s2) * (1.f / DM) + LN_EPS);
        const int cond = cond_of_row(r);
        const float* msc = which == 0 ? MODS + (size_t)(l * 3 + cond) * 12288 + 8192 : MODS + (size_t)((l + 1) * 3 + cond) * 12288 + 2048;
        const float* msh = which == 0 ? MODS + (size_t)(l * 3 + cond) * 12288 + 6144 : MODS + (size_t)((l + 1) * 3 + cond) * 12288;
#pragma unroll
        for (int j = 0; j < 8; ++j) { const int c = (F.lane + 64 * j) * 4; const f32x4 g = *(const f32x4*)(lg + c), b = *(const f32x4*)(lb + c);
            const f32x4 x = v[j] * rstd * g + b; *(f32x4*)(X + (size_t)r * DM + c) = x;
            if (!last) { const f32x4 sc = *(const f32x4*)(msc + c), sh = *(const f32x4*)(msh + c); const f32x4 h = x * (1.f + sc) + sh;
                v2u o; o.x = pk2(h[0], h[1]); o.y = pk2(h[2], h[3]); *(v2u*)(H + (size_t)r * DM + c) = o; } }
    }
}

namespace pg8 {
__device__ __forceinline__ void tile_of(int wgid, int nM, int nN, int& pm, int& pn) {
    const int nig = WGM * nN, gid = wgid / nig, fm = gid * WGM, gsz = (nM - fm) < WGM ? (nM - fm) : WGM;
    pm = fm + ((wgid % nig) % gsz); pn = (wgid % nig) / gsz;
}
struct InOrder {
    int G, c;
    __device__ __forceinline__ bool next(int i, Unit& u) const {
        const int L = i * G + c; if (L >= 1024) return false;
        const int wgid = (L & 7) * 128 + (L >> 3);
        if (wgid < 880) tile_of(wgid, 40, 22, u.pm, u.pn); else { tile_of(wgid - 880, 36, 4, u.pm, u.pn); u.pn += 22; }
        u.ks = 0; return true;
    }
    __device__ __forceinline__ void a_ready(const Unit&) const {}
    __device__ __forceinline__ void done(const Unit&) const {}
};
struct OneUnit {
    int pm, pn;
    __device__ __forceinline__ bool next(int i, Unit& u) const { if (i) return false; u.pm = pm; u.pn = pn; u.ks = 0; return true; }
    __device__ __forceinline__ void a_ready(const Unit&) const {}
    __device__ __forceinline__ void done(const Unit&) const {}
};
struct LatSplitOrder {
    int G, c;
    __device__ __forceinline__ bool next(int i, Unit& u) const {
        const int L = i * G + c; if (L >= 256) return false;
        const int id = (L & 7) * 32 + (L >> 3); u.pm = 32 + (id >> 5); u.pn = (id & 31) >> 2; u.ks = id & 3; return true;
    }
    __device__ __forceinline__ void a_ready(const Unit&) const {}
    __device__ __forceinline__ void done(const Unit&) const {}
};
struct EpiIn {
    static constexpr bool PERM = true, AFTER_DRAIN = false;
    bf16_t *Q, *KB, *VB, *HQ, *HI, *HG; float *ZF, *ZB, *outK, *outV; const float* rope;
    __device__ __forceinline__ void operator()(const f32x4 (&acc)[2][2][4][2], const Unit& u, int wr, int wc, int fr, int fq) const {
        const int pn = u.pn, rbase = u.pm * BM + wr * 64 + fr, cl = wc * 32 + 8 * fq;
        if (pn >= 10 && pn < 18) {
            float* dst = (pn < 14 ? ZF + (pn - 10) * 256 : ZB + (pn - 14) * 256) + cl;
#pragma unroll
            for (int ai = 0; ai < 2; ++ai)
#pragma unroll
                for (int m = 0; m < 4; ++m) { float* rowp = dst + (size_t)(rbase + ai * HALF + m * 16) * 1024;
#pragma unroll
                    for (int bj = 0; bj < 2; ++bj) { *(f32x4*)(rowp + bj * HALF) = acc[ai][bj][m][0]; *(f32x4*)(rowp + bj * HALF + 4) = acc[ai][bj][m][1]; } }
        } else {
            bf16_t* dst; int ld = 1024; bool act = false; float* of = nullptr;
            if (pn < 4) dst = Q + pn * 256;
            else if (pn == 4) { dst = KB; ld = 256; of = outK; }
            else if (pn == 5) { dst = VB; ld = 256; of = outV; }
            else if (pn < 10) { dst = HQ + (pn - 6) * 256; act = true; }
            else if (pn < 22) dst = HI + (pn - 18) * 256;
            else { dst = HG + (pn - 22) * 256; act = true; }
            if (u.pm >= 32) of = nullptr;
            const bool qk = pn <= 4, rot = qk && u.pm >= 32; const int half = wc >> 1, i0 = (wc & 1) * 16 + 4 * fq;
#pragma unroll
            for (int ai = 0; ai < 2; ++ai)
#pragma unroll
                for (int m = 0; m < 4; ++m) { const int row = rbase + ai * HALF + m * 16; bf16_t* rowp = dst + (size_t)row * ld + cl;
#pragma unroll
                    for (int bj = 0; bj < 2; ++bj) { f32x4 v0 = acc[ai][bj][m][0], v1 = acc[ai][bj][m][1];
                        if (rot) { const int t = (row - 8192) & 1023; const int p = half ? 16 + (t & 63) : (t >> 6); const float* rp = rope + (size_t)(p * 32 + i0) * 2;
                            const f32x4 r0 = *(const f32x4*)rp, r1 = *(const f32x4*)(rp + 4);
                            v0 = (f32x4){v0[0] * r0[0] - v0[1] * r0[1], v0[0] * r0[1] + v0[1] * r0[0], v0[2] * r0[2] - v0[3] * r0[3], v0[2] * r0[3] + v0[3] * r0[2]};
                            v1 = (f32x4){v1[0] * r1[0] - v1[1] * r1[1], v1[0] * r1[1] + v1[1] * r1[0], v1[2] * r1[2] - v1[3] * r1[3], v1[2] * r1[3] + v1[3] * r1[2]}; }
                        if (of) { float* op = of + (size_t)u.pm * 262144 + (size_t)(row - u.pm * BM) * 256 + bj * HALF;
                            if (pn == 4) { op += half * 64 + i0; *(f32x4*)op = (f32x4){v0[0], v0[2], v1[0], v1[2]}; *(f32x4*)(op + 32) = (f32x4){v0[1], v0[3], v1[1], v1[3]}; }
                            else { op += cl; *(f32x4*)op = v0; *(f32x4*)(op + 4) = v1; } }
                        if (act) {
#pragma unroll
                            for (int e = 0; e < 4; ++e) { v0[e] = siluf(v0[e]); v1[e] = siluf(v1[e]); } }
                        u32x4 w; w.x = cvt_pk_bf16(v0[0], v0[1]); w.y = cvt_pk_bf16(v0[2], v0[3]); w.z = cvt_pk_bf16(v1[0], v1[1]); w.w = cvt_pk_bf16(v1[2], v1[3]);
                        *(u32x4*)(rowp + bj * HALF) = w; } }
        }
    }
};
struct EpiRes {
    static constexpr bool PERM = false, AFTER_DRAIN = false;
    const float* xp; const float* xs; float* Y; const float* gate0;
    __device__ __forceinline__ void operator()(const f32x4 (&acc)[2][2][4][2], const Unit& u, int wr, int wc, int fr, int fq) const {
        const int cond = u.pm < 32 ? 0 : 1 + ((u.pm - 32) >> 2); const float* gate = gate0 + (size_t)cond * 12288;
        const int col0 = u.pn * BM + wc * 32 + 4 * fq; const int r0 = u.pm * BM + wr * 64 + fr;
        const float* __restrict__ xb = (u.pm < 32 ? xp + (size_t)r0 * 2048 : xs + (size_t)(r0 - 8192) * 2048) + col0; float* __restrict__ yb = Y + (size_t)r0 * 2048 + col0;
        f32x4 gv[2][2];
#pragma unroll
        for (int bj = 0; bj < 2; ++bj)
#pragma unroll
            for (int n = 0; n < 2; ++n) gv[bj][n] = *(const f32x4*)(gate + col0 + bj * HALF + n * 16);
        f32x4 xc[2][2], xn[2][2];
#pragma unroll
        for (int bj = 0; bj < 2; ++bj)
#pragma unroll
            for (int n = 0; n < 2; ++n) xc[bj][n] = *(const f32x4*)(xb + bj * HALF + n * 16);
#pragma unroll
        for (int it = 0; it < 8; ++it) { const int ai = it >> 2, m = it & 3; const size_t ro = (size_t)(ai * HALF + m * 16) * 2048;
            if (it < 7) { const int ai2 = (it + 1) >> 2, m2 = (it + 1) & 3; const size_t rn = (size_t)(ai2 * HALF + m2 * 16) * 2048;
#pragma unroll
                for (int bj = 0; bj < 2; ++bj)
#pragma unroll
                    for (int n = 0; n < 2; ++n) xn[bj][n] = *(const f32x4*)(xb + rn + bj * HALF + n * 16); }
#pragma unroll
            for (int bj = 0; bj < 2; ++bj)
#pragma unroll
                for (int n = 0; n < 2; ++n) { *(f32x4*)(yb + ro + bj * HALF + n * 16) = DN_ALPHA * xc[bj][n] + gv[bj][n] * acc[ai][bj][m][n]; xc[bj][n] = xn[bj][n]; } }
    }
};
struct EpiDown {
    static constexpr bool PERM = true, AFTER_DRAIN = false;
    bf16_t* SL; const float* gate0;
    __device__ __forceinline__ void operator()(const f32x4 (&acc)[2][2][4][2], const Unit& u, int wr, int wc, int fr, int fq) const {
        const int cond = u.pm < 32 ? 0 : 1 + ((u.pm - 32) >> 2); const float* gate = gate0 + (size_t)cond * 12288;
        const int col0 = u.pn * BM + wc * 32 + 8 * fq; const int r0 = u.pm * BM + wr * 64 + fr;
        f32x4 gv[2][2];
#pragma unroll
        for (int bj = 0; bj < 2; ++bj)
#pragma unroll
            for (int n = 0; n < 2; ++n) gv[bj][n] = *(const f32x4*)(gate + col0 + bj * HALF + n * 4);
        bf16_t* sl = SL + (size_t)u.ks * MT * 2048;
#pragma unroll
        for (int ai = 0; ai < 2; ++ai)
#pragma unroll
            for (int m = 0; m < 4; ++m) { bf16_t* sr = sl + (size_t)(r0 + ai * HALF + m * 16) * 2048 + col0;
#pragma unroll
                for (int bj = 0; bj < 2; ++bj) { const f32x4 v0 = gv[bj][0] * acc[ai][bj][m][0], v1 = gv[bj][1] * acc[ai][bj][m][1];
                    u32x4 w; w.x = cvt_pk_bf16(v0[0], v0[1]); w.y = cvt_pk_bf16(v0[2], v0[3]); w.z = cvt_pk_bf16(v1[0], v1[1]); w.w = cvt_pk_bf16(v1[2], v1[3]);
                    *(u32x4*)(sr + bj * HALF) = w; } }
    }
};
struct EpiUp {
    static constexpr bool PERM = true, AFTER_DRAIN = false;
    bf16_t* O;
    __device__ __forceinline__ void operator()(const f32x4 (&acc)[2][2][4][2], const Unit& u, int wr, int wc, int fr, int fq) const {
        const int row0 = u.pm * BM + wr * 64 + fr, col0 = u.pn * BM + wc * 32 + 8 * fq;
#pragma unroll
        for (int ai = 0; ai < 2; ++ai)
#pragma unroll
            for (int m = 0; m < 4; ++m) { bf16_t* rowp = O + (size_t)(row0 + ai * HALF + m * 16) * 8192 + col0;
#pragma unroll
                for (int bj = 0; bj < 2; ++bj) { f32x4 v0 = acc[ai][bj][m][0], v1 = acc[ai][bj][m][1];
#pragma unroll
                    for (int e = 0; e < 4; ++e) { const float a = fmaxf(v0[e], 0.f), b = fmaxf(v1[e], 0.f); v0[e] = a * a; v1[e] = b * b; }
                    u32x4 w; w.x = cvt_pk_bf16(v0[0], v0[1]); w.y = cvt_pk_bf16(v0[2], v0[3]); w.z = cvt_pk_bf16(v1[0], v1[1]); w.w = cvt_pk_bf16(v1[2], v1[3]);
                    *(u32x4*)(rowp + bj * HALF) = w; } }
    }
};
}

__device__ __forceinline__ void attn_task(const Frame& F, KArgs A, int l, int task, char* lds_gen) {
    const att::bf16* QB = (const att::bf16*)(F.ws + WS_QB); const att::bf16* KB = (const att::bf16*)(F.ws + WS_KB); const att::bf16* VB = (const att::bf16*)(F.ws + WS_VB);
    att::bf16* ATT = (att::bf16*)(F.ws + WS_ATT);
    const bool lat = task < 64;
    int h, row0, q0, kstart, nloc, sb = 0;
    if (lat) { sb = task >> 5; h = (task >> 2) & 7; const int qb = task & 3; row0 = NPR + sb * 1024; q0 = qb * 256;
        kstart = q0 - 128 < 0 ? 0 : q0 - 128; const int kend = q0 + 384 > 1024 ? 1024 : q0 + 384; nloc = (kend - kstart) >> 6; }
    else { const int t2 = task - 64; h = t2 & 7; row0 = (t2 >> 3) * 256; q0 = 0; kstart = 0; nloc = 4; }
    const int g = h >> 2;
    const size_t coff = (size_t)((sb * 4 + l) * 512) * 256 + g * 128;
    const att::bf16* Kl = KB + (size_t)(row0 + kstart) * 256 + g * 128; const att::bf16* Vl = VB + (size_t)(row0 + kstart) * 256 + g * 128;
    const att::bf16* Kc = lat ? (const att::bf16*)(F.ws + WS_CKB) + coff : Kl; const att::bf16* Vc = lat ? (const att::bf16*)(F.ws + WS_CVB) + coff : Vl;
    const float sink = GIN(11)[l * 8 + h];
    att::attn_body(QB + (size_t)(row0 + q0) * 1024 + h * 128, Kl, Vl, Kc, Vc, lat ? nloc + 8 : 4, nloc, lat, kstart, q0, sink * 1.4426950408889634f,
                   ATT + (size_t)(row0 + q0) * 1024 + h * 128, lds_gen, F.tid);
}

__device__ __forceinline__ void hgrn_task(const Frame& F, KArgs A, int l, int u) {
    const bool samp = u < 32; const int v = samp ? u : u - 32; const int bidx = v >> 4, h = (v >> 1) & 7, dir = v & 1; const int T = samp ? 1024 : 256; const int row0 = samp ? NPR + bidx * 1024 : bidx * 256;
    const float* LB = (const float*)(F.ws + WS_LB); const size_t soff = ((size_t)((bidx * 4 + l) * 8 + h)) * 16384;
    hg::hgrn_body(F.lds, F.tid, F.wave, (const float*)(F.ws + (dir ? WS_ZB : WS_ZF)), (const hg::bf16*)(F.ws + WS_HQ), (const hg::bf16*)(F.ws + WS_HI),
                  (hg::bf16*)(F.ws + (dir ? WS_OB : WS_OF)), LB + (size_t)(dir * 4 + l) * 1024 + h * 128,
                  samp ? (dir ? GIN(5) : GIN(4)) + soff : nullptr, samp ? nullptr : F.out + (dir ? OUT_SB : OUT_SF) + soff, row0, T, h * 128, dir);
}

__device__ __forceinline__ void mix_phase(const Frame& F, KArgs A, int l) {
    const int gw = F.vcu * 8 + F.wave, NGW = F.G * 8; bf16* MIX = (bf16*)(F.ws + WS_MIX);
    const bf16* ATT = (const bf16*)(F.ws + WS_ATT); const bf16* OFp = (const bf16*)(F.ws + WS_OF); const bf16* OBp = (const bf16*)(F.ws + WS_OB); const bf16* HG = (const bf16*)(F.ws + WS_HG);
    const float* ag = GIN(12) + (size_t)l * 1024 + F.lane * 16; const float* hgn = GIN(14) + (size_t)l * 128 + (F.lane & 7) * 16;
#define UNPK8(W_, o) do { const v4u w_ = (W_); o[0] = (f32x4){bflo(w_.x), bfhi(w_.x), bflo(w_.y), bfhi(w_.y)}; o[1] = (f32x4){bflo(w_.z), bfhi(w_.z), bflo(w_.w), bfhi(w_.w)}; } while (0)
    for (int r = gw; r < MT; r += NGW) {
        const size_t ro = (size_t)r * 1024 + F.lane * 16;
        f32x4 a[4]; float ss = 0.f;
        { const v4u wA = *(const v4u*)(ATT + ro), wB = *(const v4u*)(ATT + ro + 8); UNPK8(wA, (a + 0)); UNPK8(wB, (a + 2)); }
#pragma unroll
        for (int j = 0; j < 4; ++j) ss += (a[j][0] * a[j][0] + a[j][1] * a[j][1]) + (a[j][2] * a[j][2] + a[j][3] * a[j][3]);
        const float rs = 1.f / sqrtf(wave_sum(ss) * (1.f / 1024.f) + RMS_EPS);
        v4u w0, w1;
        { const f32x4 g0 = *(const f32x4*)(ag), g1 = *(const f32x4*)(ag + 4), g2 = *(const f32x4*)(ag + 8), g3 = *(const f32x4*)(ag + 12);
          const f32x4 y0 = a[0] * rs * g0, y1 = a[1] * rs * g1, y2 = a[2] * rs * g2, y3 = a[3] * rs * g3;
          w0.x = pk2(y0[0], y0[1]); w0.y = pk2(y0[2], y0[3]); w0.z = pk2(y1[0], y1[1]); w0.w = pk2(y1[2], y1[3]);
          w1.x = pk2(y2[0], y2[1]); w1.y = pk2(y2[2], y2[3]); w1.z = pk2(y3[0], y3[1]); w1.w = pk2(y3[2], y3[3]); }
        *(v4u*)(MIX + (size_t)r * 2048 + F.lane * 16) = w0; *(v4u*)(MIX + (size_t)r * 2048 + F.lane * 16 + 8) = w1;
        float s2 = 0.f;
        { const v4u fA = *(const v4u*)(OFp + ro), fB = *(const v4u*)(OFp + ro + 8), bA = *(const v4u*)(OBp + ro), bB = *(const v4u*)(OBp + ro + 8);
          f32x4 t[4]; UNPK8(fA, (a + 0)); UNPK8(fB, (a + 2)); UNPK8(bA, (t + 0)); UNPK8(bB, (t + 2));
#pragma unroll
          for (int j = 0; j < 4; ++j) { a[j] += t[j]; s2 += (a[j][0] * a[j][0] + a[j][1] * a[j][1]) + (a[j][2] * a[j][2] + a[j][3] * a[j][3]); } }
        s2 += __shfl_xor(s2, 1); s2 += __shfl_xor(s2, 2); s2 += __shfl_xor(s2, 4);
        const float r2 = 1.f / sqrtf(s2 * (1.f / 128.f) + RMS_EPS);
        const v4u gA = *(const v4u*)(HG + ro), gB = *(const v4u*)(HG + ro + 8);
        { const f32x4 g0 = *(const f32x4*)(hgn), g1 = *(const f32x4*)(hgn + 4), g2 = *(const f32x4*)(hgn + 8), g3 = *(const f32x4*)(hgn + 12);
          f32x4 t[4]; UNPK8(gA, (t + 0)); UNPK8(gB, (t + 2));
          const f32x4 y0 = a[0] * r2 * g0 * t[0], y1 = a[1] * r2 * g1 * t[1], y2 = a[2] * r2 * g2 * t[2], y3 = a[3] * r2 * g3 * t[3];
          w0.x = pk2(y0[0], y0[1]); w0.y = pk2(y0[2], y0[3]); w0.z = pk2(y1[0], y1[1]); w0.w = pk2(y1[2], y1[3]);
          w1.x = pk2(y2[0], y2[1]); w1.y = pk2(y2[2], y2[3]); w1.z = pk2(y3[0], y3[1]); w1.w = pk2(y3[2], y3[3]); }
        *(v4u*)(MIX + (size_t)r * 2048 + 1024 + F.lane * 16) = w0; *(v4u*)(MIX + (size_t)r * 2048 + 1024 + F.lane * 16 + 8) = w1;
    }
#undef UNPK8
}

__global__ void __launch_bounds__(512, 2) fwd_kernel(Args A_byval) {
    KArgs A = (KArgs)__builtin_amdgcn_kernarg_segment_ptr();
    extern __shared__ __attribute__((aligned(16))) unsigned char lds_raw[];
    Frame F;
    F.lds = (LAS unsigned char*)lds_raw; F.ws = (unsigned char*)(GAS unsigned char*)A->ws; F.out = (float*)(GAS float*)A->out; F.ctl = (unsigned*)(F.ws + WS_CTL);
    F.tid = threadIdx.x; F.lane = F.tid & 63; F.wave = __builtin_amdgcn_readfirstlane(F.tid >> 6);
    F.G = gridDim.x; { const int bx = blockIdx.x; F.vcu = (F.G % 8 == 0) ? (bx % 8) * (F.G / 8) + bx / 8 : bx; }
    volatile LAS unsigned* MISC = (volatile LAS unsigned*)(F.lds + MISC_OFF);
    for (int u = F.tid; u < (LDS_BYTES - LDSCTL_OFF) / 4; u += 512) ((LAS unsigned*)(F.lds + LDSCTL_OFF))[u] = 0u;
    __syncthreads();
    (void)xcd_barrier_post(F.ctl + CW_BAR, MISC + 8);
#define PHASE_BEGIN() do { int t_o = threadIdx.x; asm volatile("" : "+v"(t_o)); F.tid = t_o; F.lane = t_o & 63; F.wave = __builtin_amdgcn_readfirstlane(t_o >> 6); } while (0)
#define GRID_BAR() do { unsigned char* w_ = F.ws; asm volatile("" : "+s"(w_)); XcdBarrier b_; b_.bar = (unsigned*)(w_ + WS_CTL) + CW_BAR; b_.x = xb_xcc_id(); b_.st = MISC + 8; xcd_barrier(b_); } while (0)
    unsigned char* ws = F.ws;
    using pg8::bf16_t;

    p0_prologue(F, A);
    GRID_BAR(); PHASE_BEGIN();
    modulate0_phase(F, A);
    GRID_BAR(); PHASE_BEGIN();

    for (int l = 0; l < 4; ++l) {
        { int t_o = threadIdx.x; asm volatile("" : "+v"(t_o)); F.tid = t_o; F.lane = t_o & 63; F.wave = __builtin_amdgcn_readfirstlane(t_o >> 6); asm volatile("" : "+s"(A)); ws = (unsigned char*)(GAS unsigned char*)A->ws; F.ws = ws; F.out = (float*)(GAS float*)A->out; F.ctl = (unsigned*)(ws + WS_CTL); }
        const float* MODS_L = (const float*)(ws + WS_MODS) + (size_t)l * 3 * 12288;
        { pg8::Gemm g{(const bf16_t*)(ws + WS_H), (const bf16_t*)(ws + WS_WIN) + (size_t)l * IN_DIM * DM, MT, IN_DIM, DM, DM, 0, 0}; pg8::InOrder S{F.G, (int)blockIdx.x};
          pg8::EpiIn E{(bf16_t*)(ws + WS_QB), (bf16_t*)(ws + WS_KB), (bf16_t*)(ws + WS_VB), (bf16_t*)(ws + WS_HQ), (bf16_t*)(ws + WS_HI), (bf16_t*)(ws + WS_HG),
                       (float*)(ws + WS_ZF), (float*)(ws + WS_ZB), F.out + OUT_CK + (size_t)l * 65536, F.out + OUT_CV + (size_t)l * 65536, (const float*)(ws + WS_ROPE)};
          pg8::gemm_phase<pg8::EpiIn, pg8::InOrder, true, true>(F.lds, g, S, E); }
        GRID_BAR(); PHASE_BEGIN();
        for (;;) {
            if (F.tid == 0) MISC[0] = atomicAdd(F.ctl + CW_Q + 64 * l, 1u);
            __syncthreads();
            const int u = (int)MISC[0];
            __syncthreads();
            if (u >= 880) break;
            PHASE_BEGIN();
            if (u < 16) {
                pg8::Gemm g{(const bf16_t*)(ws + WS_H), (const bf16_t*)(ws + WS_WIN) + (size_t)l * IN_DIM * DM, MT, IN_DIM, DM, DM, 0, 0}; pg8::OneUnit S1{36 + (u >> 2), 22 + (u & 3)};
                pg8::EpiIn E{(bf16_t*)(ws + WS_QB), (bf16_t*)(ws + WS_KB), (bf16_t*)(ws + WS_VB), (bf16_t*)(ws + WS_HQ), (bf16_t*)(ws + WS_HI), (bf16_t*)(ws + WS_HG),
                             (float*)(ws + WS_ZF), (float*)(ws + WS_ZB), F.out + OUT_CK + (size_t)l * 65536, F.out + OUT_CV + (size_t)l * 65536, (const float*)(ws + WS_ROPE)};
                pg8::gemm_phase<pg8::EpiIn, pg8::OneUnit, true, true>(F.lds, g, S1, E);
            }
            else if (u < 48) hgrn_task(F, A, l, u - 16); else if (u >= 112 && u < 624) hgrn_task(F, A, l, u - 80);
            else if (u >= 48 && u < 112) attn_task(F, A, l, u - 48, (char*)lds_raw); else if (u >= 624) attn_task(F, A, l, u - 560, (char*)lds_raw);
        }
        GRID_BAR(); PHASE_BEGIN();
        mix_phase(F, A, l);
        GRID_BAR(); PHASE_BEGIN();
        { pg8::Gemm g{(const bf16_t*)(ws + WS_MIX), (const bf16_t*)(ws + WS_WO) + (size_t)l * DM * DM, MT, DM, DM, DM, 0, 0};
          const float* xp = l == 0 ? GIN(0) : (const float*)(ws + WS_X); const float* xs = l == 0 ? GIN(1) : (const float*)(ws + WS_X) + (size_t)NPR * DM;
          pg8::EpiRes E{xp, xs, (float*)(ws + WS_Y), MODS_L + 4096};
          { pg8::StaticOrder S; S.init(NPR, DM, F.G, (int)blockIdx.x); pg8::gemm_phase<pg8::EpiRes, pg8::StaticOrder, true, true>(F.lds, g, S, E); }
          GRID_BAR(); PHASE_BEGIN();
          if (F.G >= 128) {
              if (blockIdx.x < 64) { pg8::OneUnit S1{32 + ((int)blockIdx.x >> 3), (int)blockIdx.x & 7}; pg8::gemm_phase<pg8::EpiRes, pg8::OneUnit, true, true>(F.lds, g, S1, E); }
              else ln_phase(F, A, l, 0, 0, NPR, ((int)blockIdx.x - 64) * 8 + F.wave, (F.G - 64) * 8);
          } else {
              for (int uu = (int)blockIdx.x; uu < 64; uu += F.G) { pg8::OneUnit S1{32 + (uu >> 3), uu & 7}; pg8::gemm_phase<pg8::EpiRes, pg8::OneUnit, true, true>(F.lds, g, S1, E); }
              ln_phase(F, A, l, 0, 0, NPR, F.vcu * 8 + F.wave, F.G * 8);
          }
        }
        GRID_BAR(); PHASE_BEGIN();
        ln_phase(F, A, l, 0, NPR, MT, F.vcu * 8 + F.wave, F.G * 8);
        GRID_BAR(); PHASE_BEGIN();
        { pg8::Gemm g{(const bf16_t*)(ws + WS_H), (const bf16_t*)(ws + WS_WUP) + (size_t)l * DFF * DM, MT, DFF, DM, DM, 0, 0}; pg8::StaticOrder S; S.init(MT, DFF, F.G, (int)blockIdx.x);
          pg8::EpiUp E{(bf16_t*)(ws + WS_ACT)};
          pg8::gemm_phase<pg8::EpiUp, pg8::StaticOrder, true, true>(F.lds, g, S, E); }
        GRID_BAR(); PHASE_BEGIN();
        { pg8::Gemm g{(const bf16_t*)(ws + WS_ACT), (const bf16_t*)(ws + WS_WDN) + (size_t)l * DM * DFF, NPR, DM, DFF, DFF, 0, 0}; pg8::StaticOrder S; S.init(NPR, DM, F.G, (int)blockIdx.x);
          pg8::EpiRes E{(const float*)(ws + WS_X), (const float*)(ws + WS_X) + (size_t)NPR * DM, (float*)(ws + WS_Y), MODS_L + 10240};
          pg8::gemm_phase<pg8::EpiRes, pg8::StaticOrder, true, true>(F.lds, g, S, E); }
        PHASE_BEGIN();
        { pg8::Gemm g{(const bf16_t*)(ws + WS_ACT), (const bf16_t*)(ws + WS_WDN) + (size_t)l * DM * DFF, MT, DM, 2048, DFF, (size_t)2048 * 2, (size_t)2048 * 2}; pg8::LatSplitOrder S{F.G, (int)blockIdx.x};
          pg8::EpiDown E{(bf16_t*)(ws + WS_SL), MODS_L + 10240};
          pg8::gemm_phase<pg8::EpiDown, pg8::LatSplitOrder, true, true>(F.lds, g, S, E); }
        GRID_BAR(); PHASE_BEGIN();
        ln_phase(F, A, l, 1, 0, MT, F.vcu * 8 + F.wave, F.G * 8);
        GRID_BAR(); PHASE_BEGIN();
    }
}

extern "C" void kernel_launch(void* const* d_in, const int* in_sizes, int n_in, void* d_out, int out_size, void* d_ws, size_t ws_size, hipStream_t stream) {
    static int grid = 0;
    if (grid == 0) {
        if (n_in != 20 || ws_size < WS_END) { fprintf(stderr, "kernel_launch: unexpected n_in %d / ws %zu\n", n_in, ws_size); grid = -1; return; }
        int dev = 0, cus = 0, per_cu = 0;
        if (hipGetDevice(&dev) != hipSuccess || hipDeviceGetAttribute(&cus, hipDeviceAttributeMultiprocessorCount, dev) != hipSuccess) { grid = -1; return; }
        if (hipFuncSetAttribute((const void*)fwd_kernel, hipFuncAttributeMaxDynamicSharedMemorySize, LDS_BYTES) != hipSuccess) { fprintf(stderr, "kernel_launch: hipFuncSetAttribute failed\n"); grid = -1; return; }
        if (hipOccupancyMaxActiveBlocksPerMultiprocessor(&per_cu, (const void*)fwd_kernel, 512, LDS_BYTES) != hipSuccess || per_cu < 1) fprintf(stderr, "kernel_launch: occupancy query says %d\n", per_cu);
        (void)hipGetLastError();
        grid = cus;
    }
    if (grid < 0) return;
    if (hipMemsetAsync((char*)d_ws + WS_CTL, 0, CTL_ZERO_BYTES, stream) != hipSuccess) return;
    Args a{};
    for (int i = 0; i < 20; ++i) a.in[i] = (const float*)d_in[i];
    a.out = (float*)d_out; a.ws = (unsigned char*)d_ws;
    hipLaunchKernelGGL(fwd_kernel, dim3(grid), dim3(512), LDS_BYTES, stream, a);
}
```
